# Optimizing an MI355X kernel written in HIP

```python
import jax, jax.numpy as jnp
from jax import lax
import numpy as np

D_MODEL = 2048
BATCH = 8
SEQ = 2048
DEPTH = 1

CHUNK = 64
HEAD_DIM = 128
N_HEADS_SB = 8
N_HEADS_CA = 8
W_SB = N_HEADS_SB * HEAD_DIM
W_CA = N_HEADS_CA * HEAD_DIM
LEFT_CHUNKS = 8
BAND = (LEFT_CHUNKS + 1) * CHUNK
REL_CLIP = 128
N_REL = REL_CLIP + CHUNK
Q_BLOCK = 128
D_FF = -(-8 * D_MODEL // (3 * 256)) * 256
D_PLE = 256
EPS = 1e-6
NEG = -1e30
IN_COLS = 3 * W_SB + 3 * W_CA + 2 * D_MODEL

kernel_name = "hybrid_stickbreak_chunkrel_block"


def rmsnorm(x, g):
    xf = x.astype(jnp.float32)
    y = xf * lax.rsqrt(jnp.mean(xf * xf, axis=-1, keepdims=True) + EPS)
    return (y * g.astype(jnp.float32)).astype(x.dtype)


def stick_breaking_attention(q, k, v):
    B, S, H, Dh = q.shape
    scale = Dh ** -0.5
    outs = []
    for qb in range(S // Q_BLOCK):
        t0 = qb * Q_BLOCK
        t1 = t0 + Q_BLOCK
        kb = k[:, :t1]
        vb = v[:, :t1]
        z = jnp.einsum('bqhd,bkhd->bhqk', q[:, t0:t1], kb).astype(jnp.float32) * scale
        past = jnp.arange(t1)[None, :] < jnp.arange(t0, t1)[:, None]
        log_keep = jnp.where(past, jax.nn.log_sigmoid(-z), 0.0)
        between = lax.cumsum(log_keep, axis=3, reverse=True) - log_keep
        a = jnp.where(past, jnp.exp(jax.nn.log_sigmoid(z) + between), 0.0)
        outs.append(jnp.einsum('bhqk,bkhd->bqhd', a.astype(v.dtype), vb))
    return jnp.concatenate(outs, axis=1)


def chunked_relpos_attention(q, k, v, rel_bias):
    B, S, H, Dh = q.shape
    nc = S // CHUNK
    pad = LEFT_CHUNKS * CHUNK
    scale = Dh ** -0.5
    kp = jnp.pad(k, ((0, 0), (pad, 0), (0, 0), (0, 0)))
    vp = jnp.pad(v, ((0, 0), (pad, 0), (0, 0), (0, 0)))
    qc = jnp.moveaxis(q.reshape(B, nc, CHUNK, H, Dh), 1, 0)
    s_loc = jnp.arange(BAND)[None, :]
    rel = s_loc - (jnp.arange(CHUNK)[:, None] + pad)
    rel_idx = jnp.clip(rel, -REL_CLIP, CHUNK - 1) + REL_CLIP
    bias = rel_bias.astype(jnp.float32)[:, rel_idx]

    def one_chunk(args):
        c, qblk = args
        start = c * CHUNK
        kb = lax.dynamic_slice_in_dim(kp, start, BAND, axis=1)
        vb = lax.dynamic_slice_in_dim(vp, start, BAND, axis=1)
        valid = (start + s_loc) >= pad
        z = jnp.einsum('bqhd,bkhd->bhqk', qblk, kb).astype(jnp.float32) * scale + bias
        w = jax.nn.softmax(jnp.where(valid, z, NEG), axis=-1)
        return jnp.einsum('bhqk,bkhd->bqhd', w.astype(v.dtype), vb)

    out = lax.map(one_chunk, (jnp.arange(nc), qc))
    return jnp.moveaxis(out, 0, 1).reshape(B, S, H, Dh)


def setup_inputs(seed: int = 0) -> dict:
    key = jax.random.key(seed)
    ks = jax.random.split(key, 16)
    f32 = jnp.float32

    def w(k, shape, fan_in):
        return jax.random.normal(k, shape, f32) * fan_in ** -0.5

    def gain(k, shape):
        return 1.0 + 0.05 * jax.random.normal(k, shape, f32)

    return {
        "x": jax.random.normal(ks[0], (BATCH, SEQ, D_MODEL), f32),
        "p": jax.random.normal(ks[1], (DEPTH, BATCH, SEQ, D_PLE), f32),
        "w_in": w(ks[2], (DEPTH, D_MODEL, IN_COLS), D_MODEL),
        "w_sb_out": w(ks[3], (DEPTH, W_SB, D_MODEL), W_SB),
        "w_ca_out": w(ks[4], (DEPTH, W_CA, D_MODEL), W_CA),
        "w_mix_out": w(ks[5], (DEPTH, D_MODEL, D_MODEL), D_MODEL),
        "rel_bias": 0.3 * jax.random.normal(ks[6], (DEPTH, N_HEADS_CA, N_REL), f32),
        "g_mix": gain(ks[7], (DEPTH, D_MODEL)),
        "g_ffn": gain(ks[8], (DEPTH, D_MODEL)),
        "g_ple": gain(ks[9], (DEPTH, D_MODEL)),
        "g_final": gain(ks[10], (D_MODEL,)),
        "w_ffn_in": w(ks[11], (DEPTH, D_MODEL, 2 * D_FF), D_MODEL),
        "w_ffn_out": w(ks[12], (DEPTH, D_FF, D_MODEL), D_FF),
        "w_ple_in": w(ks[13], (DEPTH, D_PLE, D_MODEL), D_PLE),
        "w_ple_gate": w(ks[14], (DEPTH, D_MODEL, D_MODEL), D_MODEL),
    }


def reference(x, p, w_in, w_sb_out, w_ca_out, w_mix_out, rel_bias, g_mix, g_ffn, g_ple, g_final,
              w_ffn_in, w_ffn_out, w_ple_in, w_ple_gate):
    B, S, _ = x.shape
    splits = [W_SB, 2 * W_SB, 3 * W_SB, 3 * W_SB + W_CA, 3 * W_SB + 2 * W_CA, 3 * W_SB + 3 * W_CA,
              3 * W_SB + 3 * W_CA + D_MODEL]
    for i in range(DEPTH):
        h = rmsnorm(x, g_mix[i])
        proj = h @ w_in[i]
        q_sb, k_sb, v_sb, q_ca, k_ca, v_ca, gate_sb, gate_ca = jnp.split(proj, splits, axis=-1)
        y_sb = stick_breaking_attention(q_sb.reshape(B, S, N_HEADS_SB, HEAD_DIM),
                                        k_sb.reshape(B, S, N_HEADS_SB, HEAD_DIM),
                                        v_sb.reshape(B, S, N_HEADS_SB, HEAD_DIM)).reshape(B, S, W_SB)
        y_ca = chunked_relpos_attention(q_ca.reshape(B, S, N_HEADS_CA, HEAD_DIM),
                                        k_ca.reshape(B, S, N_HEADS_CA, HEAD_DIM),
                                        v_ca.reshape(B, S, N_HEADS_CA, HEAD_DIM),
                                        rel_bias[i]).reshape(B, S, W_CA)
        merged = (jax.nn.sigmoid(gate_sb) * (y_sb @ w_sb_out[i])
                  + jax.nn.sigmoid(gate_ca) * (y_ca @ w_ca_out[i]))
        x = x + merged @ w_mix_out[i]
        h = rmsnorm(x, g_ffn[i])
        g_ff, u_ff = jnp.split(h @ w_ffn_in[i], 2, axis=-1)
        x = x + (jax.nn.silu(g_ff) * u_ff) @ w_ffn_out[i]
        h = rmsnorm(x, g_ple[i])
        x = x + jax.nn.sigmoid(h @ w_ple_gate[i]) * (p[i] @ w_ple_in[i])
    return rmsnorm(x, g_final)
```

```cpp
#include <hip/hip_runtime.h>
#include <hip/hip_cooperative_groups.h>
#include <cstdio>
#include <cstdint>
namespace cg = cooperative_groups;
#ifndef XP_DUP_P0
#define XP_DUP_P0 0
#endif
#ifndef XP_DUP_P2
#define XP_DUP_P2 0
#endif
#ifndef XP_DUP_P1
#define XP_DUP_P1 0
#endif
#ifndef XP_KREP
#define XP_KREP 1
#endif
#ifndef XP_EXTRA_SYNCS
#define XP_EXTRA_SYNCS 0
#endif

#define LAS __attribute__((address_space(3)))
typedef unsigned short bf16_t;
typedef short bf16x8 __attribute__((ext_vector_type(8)));
typedef float f32x4 __attribute__((ext_vector_type(4)));
typedef float f32x16 __attribute__((ext_vector_type(16)));
typedef unsigned u32x4 __attribute__((ext_vector_type(4)));
typedef unsigned u32x2 __attribute__((ext_vector_type(2)));

constexpr int DM = 2048, NB = 8, SEQ = 2048, MTOK = NB * SEQ;
constexpr int NH = 8, HD = 128, DFF = 5632, DPLE = 256, INCOLS = 10240;
constexpr int QKP = 4096;
constexpr int NREL = 192;
constexpr float EPS = 1e-6f;
constexpr float LOG2E = 1.4426950408889634f;
constexpr float QSCALE = 0.08838834764831845f * LOG2E;

constexpr size_t MiB = 1u << 20;
constexpr size_t WS_WINA = 0 * MiB;
constexpr size_t WS_WINV = 32 * MiB;
constexpr size_t WS_WSB = 40 * MiB;
constexpr size_t WS_WCA = 44 * MiB;
constexpr size_t WS_WMIX = 48 * MiB;
constexpr size_t WS_WFI = 56 * MiB;
constexpr size_t WS_WFO = 100 * MiB;
constexpr size_t WS_WPI = 122 * MiB;
constexpr size_t WS_WPG = 123 * MiB;
constexpr size_t WS_PBF = 131 * MiB;
constexpr size_t WS_SS = 139 * MiB;
constexpr size_t WS_CTL = 139 * MiB + 512 * 1024, CTL_BYTES = 16384;
constexpr size_t WS_R1 = 140 * MiB;
constexpr size_t WS_G = 204 * MiB;
constexpr size_t WS_XN = 204 * MiB;
constexpr size_t WS_H = 268 * MiB;
constexpr size_t WS_QK = 332 * MiB;
constexpr size_t WS_END = 460 * MiB;

namespace pg8 {
constexpr int BM = 256, BK = 64, HALF = 128, HTB = HALF * BK * 2, STAGE_BYTES = 8 * HTB, NXCD = 8, WGM = 4;
__host__ __device__ __forceinline__ int lds_byte(int r, int c) { const int st = (r >> 4) * 2 + (c >> 5), rr = r & 15, cc = c & 31, ob = rr * 64 + cc * 2; return st * 1024 + (ob ^ (((ob >> 9) & 1) << 5)); }
__host__ __device__ __forceinline__ void stage_rc(int b, int& R, int& C) { const int st = b / 1024, sb = b % 1024, swz = sb ^ (((sb >> 9) & 1) << 5); R = (st >> 1) * 16 + swz / 64; C = (st & 1) * 32 + (swz % 64) / 2; }
__host__ __device__ __forceinline__ int perm32(int rho) { const int n = rho >> 4, i = rho & 15; return 8 * (i >> 2) + 4 * n + (i & 3); }

struct Unit { int pm, pn; };
struct Gemm { const bf16_t* A; const bf16_t* Bt; int M, N, K; };

struct StaticOrder {
    int nM, nN, nwg, G, c;
    __host__ __device__ void init(int M, int N, int G_, int c_) { nM = M / BM; nN = N / BM; nwg = nM * nN; G = G_; c = c_; }
    __host__ __device__ bool next(int i, Unit& u) const {
        const long L = (long)i * G + c; if (L >= nwg) return false;
        int wgid = (int)L; { const int q = nwg / NXCD, r = nwg % NXCD, xcd = wgid % NXCD, off = wgid / NXCD; wgid = (xcd < r ? xcd * (q + 1) : r * (q + 1) + (xcd - r) * q) + off; }
        const int nig = WGM * nN, gid = wgid / nig, fm = gid * WGM, gsz = (nM - fm) < WGM ? (nM - fm) : WGM;
        u.pm = fm + ((wgid % nig) % gsz); u.pn = (wgid % nig) / gsz; return true;
    }
    __device__ __forceinline__ void a_ready(const Unit&) const {}
    __device__ __forceinline__ void done(const Unit&) const {}
};

__device__ __forceinline__ unsigned cvt_pk_bf16(float lo, float hi) { unsigned r; asm volatile("v_cvt_pk_bf16_f32 %0, %1, %2" : "=v"(r) : "v"(lo), "v"(hi)); return r; }
__device__ __forceinline__ float sigmoidf_(float x) { return __builtin_amdgcn_rcpf(1.0f + __builtin_amdgcn_exp2f(-x * LOG2E)); }
__device__ __forceinline__ float bf2f(unsigned short b) { return __uint_as_float((unsigned)b << 16); }


struct EpiInProj {
    static constexpr bool PERM = true, AFTER_DRAIN = false;
    bf16_t* QK; bf16_t* G;
    __device__ __forceinline__ void operator()(const f32x4 (&acc)[2][2][4][2], const Unit& u, int wr, int wc, int fr, int fq) const {
        const int row0 = u.pm * BM + wr * 64 + fr;
        const bool isg = u.pn >= 16;
        const int pn = isg ? u.pn - 16 : u.pn;
        bf16_t* base = isg ? G : QK;
        const float sc = (((u.pn & 4) == 0) ? QSCALE : 1.0f) * (1.0f / XP_KREP);
        const int col0 = pn * BM + wc * 32 + 8 * fq;
#pragma unroll
        for (int ai = 0; ai < 2; ++ai)
#pragma unroll
            for (int m = 0; m < 4; ++m) { bf16_t* rowp = base + (size_t)(row0 + ai * HALF + m * 16) * QKP + col0;
#pragma unroll
                for (int bj = 0; bj < 2; ++bj) { f32x4 v0 = acc[ai][bj][m][0], v1 = acc[ai][bj][m][1];
                    if (isg) {
#pragma unroll
                        for (int i = 0; i < 4; ++i) { v0[i] = sigmoidf_(v0[i] * (1.0f / XP_KREP)); v1[i] = sigmoidf_(v1[i] * (1.0f / XP_KREP)); }
                    } else { v0 = v0 * sc; v1 = v1 * sc; }
                    u32x4 w; w.x = cvt_pk_bf16(v0[0], v0[1]); w.y = cvt_pk_bf16(v0[2], v0[3]); w.z = cvt_pk_bf16(v1[0], v1[1]); w.w = cvt_pk_bf16(v1[2], v1[3]);
                    *(u32x4*)(rowp + bj * HALF) = w; } }
    }
};
struct EpiBf16Plain {
    static constexpr bool PERM = true, AFTER_DRAIN = false;
    bf16_t* O; int ldc;
    __device__ __forceinline__ void operator()(const f32x4 (&acc)[2][2][4][2], const Unit& u, int wr, int wc, int fr, int fq) const {
        const int row0 = u.pm * BM + wr * 64 + fr;
        const int tb0 = u.pn * 8 + wc;
#pragma unroll
        for (int ai = 0; ai < 2; ++ai)
#pragma unroll
            for (int m = 0; m < 4; ++m) { const int row = row0 + ai * HALF + m * 16;
#pragma unroll
                for (int bj = 0; bj < 2; ++bj) { const f32x4 v0 = acc[ai][bj][m][0], v1 = acc[ai][bj][m][1];
                    u32x4 w; w.x = cvt_pk_bf16(v0[0], v0[1]); w.y = cvt_pk_bf16(v0[2], v0[3]); w.z = cvt_pk_bf16(v1[0], v1[1]); w.w = cvt_pk_bf16(v1[2], v1[3]);
                    *(u32x4*)(O + ((size_t)(tb0 + 4 * bj) * 2048 + row) * 32 + 8 * fq) = w; } }
    }
};
__device__ __forceinline__ void bf8_to_f32(const u32x4 w, f32x4& a, f32x4& b) {
    a[0] = __uint_as_float(w.x << 16); a[1] = __uint_as_float(w.x & 0xffff0000u); a[2] = __uint_as_float(w.y << 16); a[3] = __uint_as_float(w.y & 0xffff0000u);
    b[0] = __uint_as_float(w.z << 16); b[1] = __uint_as_float(w.z & 0xffff0000u); b[2] = __uint_as_float(w.w << 16); b[3] = __uint_as_float(w.w & 0xffff0000u);
}
__device__ __forceinline__ u32x4 f32_to_bf8(const f32x4 a, const f32x4 b) { u32x4 w; w.x = cvt_pk_bf16(a[0], a[1]); w.y = cvt_pk_bf16(a[2], a[3]); w.z = cvt_pk_bf16(b[0], b[1]); w.w = cvt_pk_bf16(b[2], b[3]); return w; }
template <int MODE> struct EpiGate {
    static constexpr bool PERM = true, AFTER_DRAIN = false;
    const bf16_t* G; int goff; bf16_t* TMP; bf16_t* MG;
    __device__ __forceinline__ void operator()(const f32x4 (&acc)[2][2][4][2], const Unit& u, int wr, int wc, int fr, int fq) const {
        const int col0 = u.pn * BM + wc * 32 + 8 * fq;
        u32x4 gw[2][2][2], tw[2][2][2];
#define EG_LOAD(bt, buf) do { _Pragma("unroll") for (int gi = 0; gi < 2; ++gi) { const int ai = ((bt) * 2 + gi) >> 2, m = ((bt) * 2 + gi) & 3; const size_t row = (size_t)(u.pm * BM + ai * HALF + wr * 64 + m * 16 + fr); \
            _Pragma("unroll") for (int bj = 0; bj < 2; ++bj) { const int c = col0 + bj * HALF; gw[buf][gi][bj] = *(const u32x4*)(G + row * QKP + goff + c); if (MODE == 1) tw[buf][gi][bj] = *(const u32x4*)(TMP + row * DM + c); } } } while (0)
        EG_LOAD(0, 0);
#pragma unroll
        for (int bt = 0; bt < 4; ++bt) {
            if (bt + 1 < 4) EG_LOAD(bt + 1, (bt + 1) & 1);
#pragma unroll
            for (int gi = 0; gi < 2; ++gi) { const int ai = (bt * 2 + gi) >> 2, m = (bt * 2 + gi) & 3; const size_t row = (size_t)(u.pm * BM + ai * HALF + wr * 64 + m * 16 + fr);
#pragma unroll
                for (int bj = 0; bj < 2; ++bj) { const int c = col0 + bj * HALF;
                    f32x4 g0, g1; bf8_to_f32(gw[bt & 1][gi][bj], g0, g1);
                    f32x4 v0 = acc[ai][bj][m][0] * g0, v1 = acc[ai][bj][m][1] * g1;
                    if (MODE == 1) { f32x4 t0, t1; bf8_to_f32(tw[bt & 1][gi][bj], t0, t1); v0 = v0 + t0; v1 = v1 + t1; }
                    *(u32x4*)((MODE == 0 ? TMP : MG) + row * DM + c) = f32_to_bf8(v0, v1); } }
            asm volatile("" ::: "memory"); }
#undef EG_LOAD
    }
};
template <bool BASE_BF16> struct EpiResid {
    static constexpr bool PERM = true, AFTER_DRAIN = false;
    const float* basef; bf16_t* X; float* ss;
    __device__ __forceinline__ void operator()(const f32x4 (&acc)[2][2][4][2], const Unit& u, int wr, int wc, int fr, int fq) const {
        const int col0 = u.pn * BM + wc * 32 + 8 * fq;
        f32x4 bsf[2][BASE_BF16 ? 1 : 2][2][2]; u32x4 bsh[2][BASE_BF16 ? 2 : 1][2];
#define ER_LOAD(bt, buf) do { _Pragma("unroll") for (int gi = 0; gi < 2; ++gi) { const int ai = ((bt) * 2 + gi) >> 2, m = ((bt) * 2 + gi) & 3; const size_t row = (size_t)(u.pm * BM + ai * HALF + wr * 64 + m * 16 + fr); \
            _Pragma("unroll") for (int bj = 0; bj < 2; ++bj) { const int c = col0 + bj * HALF; \
                if (BASE_BF16) bsh[buf][BASE_BF16 ? gi : 0][bj] = *(const u32x4*)(X + row * DM + c); \
                else { bsf[buf][BASE_BF16 ? 0 : gi][bj][0] = *(const f32x4*)(basef + row * DM + c); bsf[buf][BASE_BF16 ? 0 : gi][bj][1] = *(const f32x4*)(basef + row * DM + c + 4); } } } } while (0)
        ER_LOAD(0, 0);
#pragma unroll
        for (int bt = 0; bt < 4; ++bt) {
            if (bt + 1 < 4) ER_LOAD(bt + 1, (bt + 1) & 1);
#pragma unroll
            for (int gi = 0; gi < 2; ++gi) { const int ai = (bt * 2 + gi) >> 2, m = (bt * 2 + gi) & 3; const size_t row = (size_t)(u.pm * BM + ai * HALF + wr * 64 + m * 16 + fr); float q = 0.f;
#pragma unroll
                for (int bj = 0; bj < 2; ++bj) { const int c = col0 + bj * HALF;
                    f32x4 b0, b1;
                    if (BASE_BF16) bf8_to_f32(bsh[bt & 1][BASE_BF16 ? gi : 0][bj], b0, b1); else { b0 = bsf[bt & 1][BASE_BF16 ? 0 : gi][bj][0]; b1 = bsf[bt & 1][BASE_BF16 ? 0 : gi][bj][1]; }
                    const f32x4 x0 = b0 + acc[ai][bj][m][0], x1 = b1 + acc[ai][bj][m][1];
                    *(u32x4*)(X + row * DM + c) = f32_to_bf8(x0, x1);
                    q += ((x0[0] * x0[0] + x0[1] * x0[1]) + (x0[2] * x0[2] + x0[3] * x0[3])) + ((x1[0] * x1[0] + x1[1] * x1[1]) + (x1[2] * x1[2] + x1[3] * x1[3])); }
                q += __shfl_xor(q, 16); q += __shfl_xor(q, 32);
                if (fq == 0) __hip_atomic_fetch_add(ss + row, q, __ATOMIC_RELAXED, __HIP_MEMORY_SCOPE_AGENT); }
            asm volatile("" ::: "memory"); }
#undef ER_LOAD
    }
};
struct EpiSwiGLU {
    static constexpr bool PERM = true, AFTER_DRAIN = false;
    bf16_t* H; const float* ss;
    __device__ __forceinline__ void operator()(const f32x4 (&acc)[2][2][4][2], const Unit& u, int wr, int wc, int fr, int fq) const {
        const int col0 = u.pn * HALF + wc * 32 + 8 * fq;
#pragma unroll
        for (int ai = 0; ai < 2; ++ai)
#pragma unroll
            for (int m = 0; m < 4; ++m) { const size_t row = (size_t)(u.pm * BM + ai * HALF + wr * 64 + m * 16 + fr);
                const float rs = __builtin_amdgcn_rsqf(ss[row] * (1.0f / DM) + EPS);
                float o[8];
#pragma unroll
                for (int n = 0; n < 2; ++n)
#pragma unroll
                    for (int i = 0; i < 4; ++i) { const float g = acc[ai][0][m][n][i] * rs, uu = acc[ai][1][m][n][i] * rs; o[n * 4 + i] = g * sigmoidf_(g) * uu; }
                u32x4 w; w.x = cvt_pk_bf16(o[0], o[1]); w.y = cvt_pk_bf16(o[2], o[3]); w.z = cvt_pk_bf16(o[4], o[5]); w.w = cvt_pk_bf16(o[6], o[7]);
                *(u32x4*)(H + row * DFF + col0) = w; }
    }
};
struct EpiStoreBf16T {
    static constexpr bool PERM = false, AFTER_DRAIN = false;
    bf16_t* TMP;
    __device__ __forceinline__ void operator()(const f32x4 (&acc)[2][2][4][2], const Unit& u, int wr, int wc, int fr, int fq) const {
        const int col0 = u.pn * BM + wc * 32 + 4 * fq;
#pragma unroll
        for (int ai = 0; ai < 2; ++ai)
#pragma unroll
            for (int m = 0; m < 4; ++m) { const size_t row = (size_t)(u.pm * BM + ai * HALF + wr * 64 + m * 16 + fr);
#pragma unroll
                for (int bj = 0; bj < 2; ++bj)
#pragma unroll
                    for (int n = 0; n < 2; ++n) { const f32x4 v = acc[ai][bj][m][n]; u32x2 w; w.x = cvt_pk_bf16(v[0], v[1]); w.y = cvt_pk_bf16(v[2], v[3]);
                        *(u32x2*)(TMP + row * DM + col0 + bj * HALF + n * 16) = w; } }
    }
};
struct EpiPle {
    static constexpr bool PERM = true, AFTER_DRAIN = false;
    const bf16_t* X; bf16_t* XB; const bf16_t* TMP; const float* ssin; float* ssout;
    __device__ __forceinline__ void operator()(const f32x4 (&acc)[2][2][4][2], const Unit& u, int wr, int wc, int fr, int fq) const {
        const int col0 = u.pn * BM + wc * 32 + 8 * fq;
#pragma unroll
        for (int ai = 0; ai < 2; ++ai)
#pragma unroll
            for (int mp = 0; mp < 2; ++mp) {
                u32x4 xs[2][2]; u32x4 tw[2][2]; float sv[2];
#pragma unroll
                for (int mm = 0; mm < 2; ++mm) { const int m = mp * 2 + mm; const size_t row = (size_t)(u.pm * BM + ai * HALF + wr * 64 + m * 16 + fr);
                    sv[mm] = ssin[row];
#pragma unroll
                    for (int bj = 0; bj < 2; ++bj) { const int c = col0 + bj * HALF; xs[mm][bj] = *(const u32x4*)(X + row * DM + c); tw[mm][bj] = *(const u32x4*)(TMP + row * DM + c); } }
#pragma unroll
                for (int mm = 0; mm < 2; ++mm) { const int m = mp * 2 + mm; const size_t row = (size_t)(u.pm * BM + ai * HALF + wr * 64 + m * 16 + fr); float q = 0.f;
                    const float rs = __builtin_amdgcn_rsqf(sv[mm] * (1.0f / DM) + EPS);
#pragma unroll
                    for (int bj = 0; bj < 2; ++bj) { const int c = col0 + bj * HALF;
                        f32x4 t0, t1, x0, x1; bf8_to_f32(tw[mm][bj], t0, t1); bf8_to_f32(xs[mm][bj], x0, x1);
                        const f32x4 a0 = acc[ai][bj][m][0], a1 = acc[ai][bj][m][1];
#pragma unroll
                        for (int i = 0; i < 4; ++i) { x0[i] += sigmoidf_(a0[i] * rs) * t0[i]; x1[i] += sigmoidf_(a1[i] * rs) * t1[i]; }
                        *(u32x4*)(XB + row * DM + c) = f32_to_bf8(x0, x1);
                        q += ((x0[0] * x0[0] + x0[1] * x0[1]) + (x0[2] * x0[2] + x0[3] * x0[3])) + ((x1[0] * x1[0] + x1[1] * x1[1]) + (x1[2] * x1[2] + x1[3] * x1[3])); }
                    q += __shfl_xor(q, 16); q += __shfl_xor(q, 32);
                    if (fq == 0) __hip_atomic_fetch_add(ssout + row, q, __ATOMIC_RELAXED, __HIP_MEMORY_SCOPE_AGENT); }
                asm volatile("" ::: "memory"); }
    }
};

template <class Epi, class Sched, bool ALIGN_EPI = false, bool SP2 = false, int KREP = 1>
__device__ __forceinline__ void gemm_phase(LAS unsigned char* lds, const Gemm g, const Sched& S, const Epi& E) {
    int tid_ = threadIdx.x; asm volatile("" : "+v"(tid_));
    const int tid = tid_, wid = __builtin_amdgcn_readfirstlane(tid >> 6), lane = tid & 63, wr = wid >> 2, wc = wid & 3, fr = lane & 15, fq = lane >> 4;
    const int K = g.K, nt = K / BK;
    unsigned voffA[2], voffB[2];
#pragma unroll
    for (int i = 0; i < 2; ++i) { int R, C; stage_rc(tid * 16 + i * 8192, R, C); const int Rb = Epi::PERM ? ((R & ~31) + perm32(R & 31)) : R;
        voffA[i] = (unsigned)(R * K + C) * 2u; voffB[i] = (unsigned)(Rb * K + C) * 2u; }
    const size_t kstep = (size_t)(BK * 2);
    const size_t hstep = (size_t)HALF * K * 2;
    const size_t tstep = 2 * hstep;
    const unsigned ldsw = (unsigned)wid * 1024u;
    const int aoff = lds_byte(wr * 64 + fr, fq * 8), boff = lds_byte(wc * 32 + fr, fq * 8);
#define PG8_SA(b, h) (((b) * 2 + (h)) * HTB)
#define PG8_SB(b, h) ((4 + (b) * 2 + (h)) * HTB)
#define PG8_STAGE(bufoff, gbase, voff) do { _Pragma("unroll") for (int _i = 0; _i < 2; ++_i) \
        __builtin_amdgcn_global_load_lds((const unsigned*)((const char*)(gbase) + (voff)[_i]), (LAS unsigned*)(lds + (bufoff) + ldsw + _i * 8192), 16, 0, 0); } while (0)
#define PG8_LDA(dst, b, h) do { _Pragma("unroll") for (int m = 0; m < 4; ++m) _Pragma("unroll") for (int k = 0; k < 2; ++k) dst[m][k] = *(const LAS bf16x8*)(lds + PG8_SA(b, h) + aoff + m * 2048 + k * 1024); } while (0)
#define PG8_LDB(dst, b, h) do { _Pragma("unroll") for (int n = 0; n < 2; ++n) _Pragma("unroll") for (int k = 0; k < 2; ++k) dst[n][k] = *(const LAS bf16x8*)(lds + PG8_SB(b, h) + boff + n * 2048 + k * 1024); } while (0)
#define PG8_MMA(ai, bj, At, Bt) do { __builtin_amdgcn_s_setprio(1); _Pragma("unroll") for (int m = 0; m < 4; ++m) _Pragma("unroll") for (int n = 0; n < 2; ++n) _Pragma("unroll") for (int k = 0; k < 2; ++k) \
        acc[ai][bj][m][n] = __builtin_amdgcn_mfma_f32_16x16x32_bf16(Bt[n][k], At[m][k], acc[ai][bj][m][n], 0, 0, 0); __builtin_amdgcn_s_setprio(0); } while (0)
#define PG8_WAIT_V(n) asm volatile("s_waitcnt vmcnt(" #n ")" ::: "memory")
#define PG8_WAIT_L(n) asm volatile("s_waitcnt lgkmcnt(" #n ")" ::: "memory")
#define PG8_BAR __builtin_amdgcn_s_barrier()
#define PG8_SCHED __builtin_amdgcn_sched_barrier(0)
    Unit cur, nxt; int ui = 0;
    if (!S.next(0, cur)) return;
    f32x4 acc[2][2][4][2];
#pragma unroll
    for (int a = 0; a < 2; ++a)
#pragma unroll
        for (int b = 0; b < 2; ++b)
#pragma unroll
            for (int m = 0; m < 4; ++m)
#pragma unroll
                for (int n = 0; n < 2; ++n) acc[a][b][m][n] = (f32x4){0.f, 0.f, 0.f, 0.f};
    bf16x8 At[4][2], B0[2][2], B1[2][2];
    const char* cA = (const char*)g.A + (size_t)cur.pm * tstep; const char* cB = (const char*)g.Bt + (size_t)cur.pn * tstep;
    S.a_ready(cur);
    if constexpr (SP2) {
        PG8_STAGE(PG8_SB(0, 0), cB, voffB); PG8_STAGE(PG8_SB(0, 1), cB + hstep, voffB); PG8_STAGE(PG8_SA(0, 0), cA, voffA); PG8_STAGE(PG8_SA(0, 1), cA + hstep, voffA);
        if (wr == 1) PG8_BAR;
        PG8_WAIT_V(2); PG8_BAR;
        PG8_STAGE(PG8_SB(1, 0), cB + kstep, voffB); PG8_STAGE(PG8_SA(1, 0), cA + kstep, voffA); PG8_STAGE(PG8_SB(1, 1), cB + hstep + kstep, voffB);
        PG8_WAIT_V(6); PG8_BAR;
    } else {
        PG8_STAGE(PG8_SB(0, 0), cB, voffB); PG8_STAGE(PG8_SA(0, 0), cA, voffA); PG8_STAGE(PG8_SB(0, 1), cB + hstep, voffB); PG8_STAGE(PG8_SA(0, 1), cA + hstep, voffA);
        if (wr == 1) PG8_BAR;
        PG8_WAIT_V(4); PG8_BAR;
        PG8_STAGE(PG8_SB(1, 0), cB + kstep, voffB); PG8_STAGE(PG8_SA(1, 0), cA + kstep, voffA); PG8_STAGE(PG8_SB(1, 1), cB + hstep + kstep, voffB);
        PG8_WAIT_V(6); PG8_BAR;
    }
    for (;;) {
        const bool has_next = S.next(ui + 1, nxt);
        const char* nA = has_next ? (const char*)g.A + (size_t)nxt.pm * tstep : cA; const char* nB = has_next ? (const char*)g.Bt + (size_t)nxt.pn * tstep : cB;
        for (int t = 0; t < nt * KREP; t += 2) {
            const bool last = (t == nt * KREP - 2);
            const int t1 = (KREP == 1) ? t + 1 : ((t + 1) & (nt - 1)), t2 = (KREP == 1) ? t + 2 : ((t + 2) & (nt - 1));
            const char* a1 = cA + (size_t)t1 * kstep;
            const char* a2 = last ? nA : cA + (size_t)t2 * kstep; const char* b2 = last ? nB : cB + (size_t)t2 * kstep;
            const char* a3 = a2 + kstep; const char* b3 = b2 + kstep;
            if (last && has_next) S.a_ready(nxt);
            if constexpr (SP2) {
            PG8_LDB(B0, 0, 0); PG8_LDB(B1, 0, 1); PG8_SCHED; PG8_LDA(At, 0, 0); PG8_STAGE(PG8_SA(1, 1), a1 + hstep, voffA);
            PG8_WAIT_V(8); PG8_WAIT_L(0); PG8_BAR; PG8_MMA(0, 0, At, B0); PG8_MMA(0, 1, At, B1); PG8_BAR; PG8_SCHED;
            PG8_LDA(At, 0, 1); PG8_STAGE(PG8_SB(0, 0), b2, voffB); PG8_STAGE(PG8_SB(0, 1), b2 + hstep, voffB); PG8_STAGE(PG8_SA(0, 0), a2, voffA);
            PG8_WAIT_V(8); PG8_WAIT_L(0); PG8_BAR; PG8_MMA(1, 0, At, B0); PG8_MMA(1, 1, At, B1); PG8_BAR; PG8_SCHED;
            PG8_LDB(B0, 1, 0); PG8_LDB(B1, 1, 1); PG8_SCHED; PG8_LDA(At, 1, 0); PG8_STAGE(PG8_SA(0, 1), a2 + hstep, voffA);
            PG8_WAIT_V(8); PG8_WAIT_L(0); PG8_BAR; PG8_MMA(0, 0, At, B0); PG8_MMA(0, 1, At, B1); PG8_BAR; PG8_SCHED;
            PG8_LDA(At, 1, 1); PG8_STAGE(PG8_SB(1, 0), b3, voffB); PG8_STAGE(PG8_SB(1, 1), b3 + hstep, voffB); PG8_STAGE(PG8_SA(1, 0), a3, voffA);
            PG8_WAIT_V(8); PG8_WAIT_L(0); PG8_BAR; PG8_MMA(1, 0, At, B0); PG8_MMA(1, 1, At, B1); PG8_BAR; PG8_SCHED;
            } else {
            PG8_LDB(B0, 0, 0); PG8_SCHED; PG8_LDA(At, 0, 0); PG8_STAGE(PG8_SA(1, 1), a1 + hstep, voffA);
            PG8_WAIT_L(8); PG8_BAR; PG8_WAIT_L(0); PG8_MMA(0, 0, At, B0); PG8_BAR; PG8_SCHED;
            PG8_LDB(B1, 0, 1); PG8_STAGE(PG8_SB(0, 0), b2, voffB);
            PG8_BAR; PG8_WAIT_L(0); PG8_MMA(0, 1, At, B1); PG8_BAR;
            PG8_LDA(At, 0, 1); PG8_STAGE(PG8_SA(0, 0), a2, voffA);
            PG8_BAR; PG8_WAIT_L(0); PG8_MMA(1, 0, At, B0); PG8_BAR; PG8_SCHED;
            PG8_STAGE(PG8_SB(0, 1), b2 + hstep, voffB);
            PG8_WAIT_V(6); PG8_BAR; PG8_MMA(1, 1, At, B1); PG8_BAR;
            PG8_LDB(B0, 1, 0); PG8_SCHED; PG8_LDA(At, 1, 0); PG8_STAGE(PG8_SA(0, 1), a2 + hstep, voffA);
            PG8_WAIT_L(8); PG8_BAR; PG8_WAIT_L(0); PG8_MMA(0, 0, At, B0); PG8_BAR; PG8_SCHED;
            PG8_LDB(B1, 1, 1); PG8_STAGE(PG8_SB(1, 0), b3, voffB);
            PG8_BAR; PG8_WAIT_L(0); PG8_MMA(0, 1, At, B1); PG8_BAR;
            PG8_LDA(At, 1, 1); PG8_STAGE(PG8_SA(1, 0), a3, voffA);
            PG8_BAR; PG8_WAIT_L(0); PG8_MMA(1, 0, At, B0); PG8_BAR; PG8_SCHED;
            PG8_STAGE(PG8_SB(1, 1), b3 + hstep, voffB);
            PG8_WAIT_V(6); PG8_BAR; PG8_MMA(1, 1, At, B1); PG8_BAR;
            }
        }
        if constexpr (ALIGN_EPI) { if (wr == 0) PG8_BAR; }
        if constexpr (!Epi::AFTER_DRAIN) { E(acc, cur, wr, wc, fr, fq); S.done(cur); }
        if (!has_next) break;
#pragma unroll
        for (int a = 0; a < 2; ++a)
#pragma unroll
            for (int b = 0; b < 2; ++b)
#pragma unroll
                for (int m = 0; m < 4; ++m)
#pragma unroll
                    for (int n = 0; n < 2; ++n) acc[a][b][m][n] = (f32x4){0.f, 0.f, 0.f, 0.f};
        cur = nxt; cA = nA; cB = nB; ++ui;
        if constexpr (ALIGN_EPI) { if (wr == 1) PG8_BAR; }
    }
    PG8_WAIT_V(0);
    if constexpr (!ALIGN_EPI) { if (wr == 0) PG8_BAR; }
    PG8_BAR;
#undef PG8_SA
#undef PG8_SB
#undef PG8_STAGE
#undef PG8_LDA
#undef PG8_LDB
#undef PG8_MMA
#undef PG8_WAIT_V
#undef PG8_WAIT_L
#undef PG8_BAR
#undef PG8_SCHED
}
}

__device__ __forceinline__ unsigned f2bf(float f) { unsigned u = __builtin_bit_cast(unsigned, f); return (u + 0x7fffu + ((u >> 16) & 1u)) >> 16; }
__device__ __forceinline__ unsigned pk2(float lo, float hi) { return f2bf(lo) | (f2bf(hi) << 16); }
__device__ __forceinline__ float wave_sum(float v) {
#pragma unroll
    for (int o = 1; o < 64; o <<= 1) v += __shfl_xor(v, o);
    return v;
}
__device__ __forceinline__ void tr_item(const float* W, int K, int ldw, int col0, int ncols, bf16_t* WT, int dst_row0, bool ffmap, const float* gain  , LAS float* scr, int item, int lane) {
    const int nblk = ncols / 64, kb = item / nblk, nb = item % nblk, k0 = 64 * kb, n0 = 64 * nb;
    const int kr = lane >> 4, nc = lane & 15;
    const float* src = W + (size_t)(k0 + kr) * ldw + col0 + n0 + 4 * nc;
    f32x4 v[16];
#pragma unroll
    for (int i = 0; i < 16; ++i) v[i] = *(const f32x4*)(src + (size_t)(4 * i) * ldw);
    if (gain) {
#pragma unroll
        for (int i = 0; i < 16; ++i) v[i] = v[i] * gain[k0 + 4 * i + kr];
    }
#pragma unroll
    for (int i = 0; i < 16; ++i) { LAS float* d = scr + (4 * i + kr) * 65 + 4 * nc; d[0] = v[i].x; d[1] = v[i].y; d[2] = v[i].z; d[3] = v[i].w; }
    asm volatile("s_waitcnt lgkmcnt(0)" ::: "memory");
    int rbase;
    if (ffmap) { int j = n0; int isu = 0; if (j >= DFF) { j -= DFF; isu = 128; } rbase = 256 * (j >> 7) + isu + (j & 127); }
    else rbase = dst_row0 + n0;
    const int c = lane & 7;
#pragma unroll
    for (int j = 0; j < 8; ++j) { const int n = (lane >> 3) + 8 * j; const LAS float* sp = scr + (8 * c) * 65 + n;
        u32x4 o; o.x = pg8::cvt_pk_bf16(sp[0 * 65], sp[1 * 65]); o.y = pg8::cvt_pk_bf16(sp[2 * 65], sp[3 * 65]); o.z = pg8::cvt_pk_bf16(sp[4 * 65], sp[5 * 65]); o.w = pg8::cvt_pk_bf16(sp[6 * 65], sp[7 * 65]);
        *(u32x4*)(WT + (size_t)(rbase + n) * K + k0 + 8 * c) = o; }
    asm volatile("s_waitcnt lgkmcnt(0)" ::: "memory");
}
__device__ __forceinline__ void x_row_to_bf16(const float* xrow, bf16_t* orow, int lane) {
    const f32x4* xr = (const f32x4*)xrow + lane;
    f32x4 v[8]; float s = 0.f;
#pragma unroll
    for (int j = 0; j < 8; ++j) { v[j] = xr[64 * j]; s += (v[j].x * v[j].x + v[j].y * v[j].y) + (v[j].z * v[j].z + v[j].w * v[j].w); }
    const float rs = 1.0f / sqrtf(wave_sum(s) * (1.0f / DM) + EPS);
    u32x2* o8 = (u32x2*)orow + lane;
#pragma unroll
    for (int j = 0; j < 8; ++j) { const f32x4 y = v[j] * rs; u32x2 w; w.x = pg8::cvt_pk_bf16(y.x, y.y); w.y = pg8::cvt_pk_bf16(y.z, y.w); o8[64 * j] = w; }
}

__device__ __forceinline__ int pi32(int i) { const int g = (i >> 2) & 3; const int g2 = (g == 1) ? 2 : ((g == 2) ? 1 : g); return (i & 16) | (g2 << 2) | (i & 3); }
__device__ __forceinline__ unsigned cvtpk(float lo, float hi) { unsigned r; asm volatile("v_cvt_pk_bf16_f32 %0, %1, %2" : "=v"(r) : "v"(lo), "v"(hi)); return r; }
#define MFMA32(a, b, c) __builtin_amdgcn_mfma_f32_32x32x16_bf16((a), (b), (c), 0, 0, 0)

struct AttnTile {
    LAS unsigned char* wl;
    const bf16_t* kb; const bf16_t* vb;
    unsigned kgo[4];
    unsigned vgo;
    int kro, vro0, vro1;
};
__device__ __forceinline__ void attn_tile_init(AttnTile& T, LAS unsigned char* wl, const bf16_t* Kbase  , const bf16_t* Vbase  , int lane) {
    T.wl = wl; T.kb = Kbase; T.vb = Vbase;
    const int l4 = lane >> 4, c0 = lane & 15;
#pragma unroll
    for (int g = 0; g < 4; ++g) T.kgo[g] = (unsigned)(l4 * QKP + ((c0 ^ (4 * g + l4)) * 8));
    const int vr = lane >> 2, vc = (lane & 3) ^ ((vr >> 2) & 3);
    T.vgo = (unsigned)(vr * 32 + vc * 8);
    const int r32 = lane & 31, hi = lane >> 5, sw = (r32 >> 2) & 3;
    T.kro = r32 * 256;
    T.vro0 = 8192 + r32 * 64 + ((hi ^ sw) * 16);
    T.vro1 = 8192 + r32 * 64 + (((2 + hi) ^ sw) * 16);
}
__device__ __forceinline__ void attn_issue_k(const AttnTile& T, int sb) {
#pragma unroll
    for (int i = 0; i < 8; ++i) { const int g = i & 3; const int pi_i = (i & 4) | ((g == 1) ? 2 : ((g == 2) ? 1 : g));
        __builtin_amdgcn_global_load_lds((const unsigned*)(T.kb + (size_t)(sb + 4 * pi_i) * QKP + T.kgo[g]), (LAS unsigned*)(T.wl + i * 1024), 16, 0, 0); }
}
__device__ __forceinline__ void attn_issue_v(const AttnTile& T, int sb) {
#pragma unroll
    for (int i = 0; i < 8; ++i)
        __builtin_amdgcn_global_load_lds((const unsigned*)(T.vb + (size_t)(sb >> 5) * 65536 + (16 * i) * 32 + T.vgo), (LAS unsigned*)(T.wl + 8192 + i * 1024), 16, 0, 0);
}
__device__ __forceinline__ void attn_read_k(const AttnTile& T, bf16x8 (&kf)[8], int lane) {
    const int r15 = lane & 15, hi = lane >> 5;
#pragma unroll
    for (int ks = 0; ks < 8; ++ks) kf[ks] = *(const LAS bf16x8*)(T.wl + T.kro + (((2 * ks + hi) ^ r15) * 16));
}
__device__ __forceinline__ void attn_read_v(const AttnTile& T, bf16x8 (&vf)[4][2]) {
#pragma unroll
    for (int d = 0; d < 4; ++d) { vf[d][0] = *(const LAS bf16x8*)(T.wl + T.vro0 + d * 2048); vf[d][1] = *(const LAS bf16x8*)(T.wl + T.vro1 + d * 2048); }
}
__device__ __forceinline__ void attn_store_o(const AttnTile& T, const f32x16 (&o)[4], float scale, bf16_t* Yrow0  , int lane) {
    const int r32 = lane & 31, hi = lane >> 5;
#pragma unroll
    for (int d = 0; d < 4; ++d)
#pragma unroll
        for (int g = 0; g < 4; ++g) { u32x2 w; w.x = cvtpk(o[d][4 * g] * scale, o[d][4 * g + 1] * scale); w.y = cvtpk(o[d][4 * g + 2] * scale, o[d][4 * g + 3] * scale);
            *(LAS u32x2*)(T.wl + r32 * 256 + (((4 * d + g) ^ (r32 & 15)) * 16) + hi * 8) = w; }
    asm volatile("s_waitcnt lgkmcnt(0)" ::: "memory");
    const int l4 = lane >> 4, cs = lane & 15;
#pragma unroll
    for (int i = 0; i < 8; ++i) { const int row = 4 * i + l4; const u32x4 v = *(const LAS u32x4*)(T.wl + row * 256 + cs * 16);
        *(u32x4*)(Yrow0 + (size_t)row * 1024 + ((cs ^ (row & 15)) * 8)) = v; }
    asm volatile("s_waitcnt lgkmcnt(0)" ::: "memory");
}

__device__ __forceinline__ void sb_unit(const bf16_t* __restrict__ QK, const bf16_t* __restrict__ VT, bf16_t* __restrict__ Y, LAS unsigned char* wl, int b, int h, int qb, int lane) {
    const int r32 = lane & 31, hi = lane >> 5, t0 = qb * 32, q = t0 + r32;
    const size_t rowbase = (size_t)b * SEQ;
    AttnTile T; attn_tile_init(T, wl, QK + rowbase * QKP + 1024 + h * HD, VT + (size_t)b * (SEQ / 32) * 65536 + (size_t)(h * HD) * 32, lane);
    const bf16_t* Qp = QK + (rowbase + q) * QKP + h * HD + 8 * hi;
    bf16x8 qf[8];
#pragma unroll
    for (int ks = 0; ks < 8; ++ks) qf[ks] = *(const bf16x8*)(Qp + 16 * ks);
    attn_issue_k(T, t0); attn_issue_v(T, t0);
    f32x16 o[4];
#pragma unroll
    for (int d = 0; d < 4; ++d)
#pragma unroll
        for (int r = 0; r < 16; ++r) o[d][r] = 0.f;
    float carry = 1.0f;
    for (int sb = t0; sb >= 0; sb -= 32) {
        bf16x8 kf[8];
        asm volatile("s_waitcnt vmcnt(8)" ::: "memory");
        attn_read_k(T, kf, lane);
        asm volatile("s_waitcnt lgkmcnt(0)" ::: "memory");
        const bool more = sb > 0;
        if (more) attn_issue_k(T, sb - 32);
        f32x16 s;
#pragma unroll
        for (int r = 0; r < 16; ++r) s[r] = 0.f;
#pragma unroll
        for (int ks = 0; ks < 8; ++ks) s = MFMA32(kf[ks], qf[ks], s);
        float u[16];
#pragma unroll
        for (int r = 0; r < 16; ++r) u[r] = __builtin_amdgcn_rcpf(1.0f + __builtin_amdgcn_exp2f(s[r]));
        if (sb == t0) {
#pragma unroll
            for (int r = 0; r < 16; ++r) { const int key = sb + 16 * (r >> 3) + 8 * hi + (r & 7); u[r] = (key < q) ? u[r] : 1.0f; }
        }
        float S[16];
        S[7] = u[7]; S[15] = u[15];
#pragma unroll
        for (int r = 6; r >= 0; --r) { S[r] = u[r] * S[r + 1]; S[r + 8] = u[r + 8] * S[r + 9]; }
        const float TA = S[0], TB = S[8];
        const float pTA = __shfl_xor(TA, 32), pTB = __shfl_xor(TB, 32);
        const float offB = hi ? carry : carry * pTB;
        const float offA = (carry * TB) * (hi ? pTB : pTB * pTA);
        float a[16];
#pragma unroll
        for (int r = 0; r < 16; ++r) { const float ex = ((r & 7) == 7) ? 1.0f : S[r + 1]; a[r] = (1.0f - u[r]) * (ex * ((r < 8) ? offA : offB)); }
        carry *= (TA * TB) * (pTA * pTB);
        u32x4 p0, p1;
        p0.x = cvtpk(a[0], a[1]); p0.y = cvtpk(a[2], a[3]); p0.z = cvtpk(a[4], a[5]); p0.w = cvtpk(a[6], a[7]);
        p1.x = cvtpk(a[8], a[9]); p1.y = cvtpk(a[10], a[11]); p1.z = cvtpk(a[12], a[13]); p1.w = cvtpk(a[14], a[15]);
        const bf16x8 pb0 = __builtin_bit_cast(bf16x8, p0), pb1 = __builtin_bit_cast(bf16x8, p1);
        bf16x8 vf[4][2];
        if (more) asm volatile("s_waitcnt vmcnt(8)" ::: "memory"); else asm volatile("s_waitcnt vmcnt(0)" ::: "memory");
        attn_read_v(T, vf);
        asm volatile("s_waitcnt lgkmcnt(0)" ::: "memory");
        if (more) attn_issue_v(T, sb - 32);
#pragma unroll
        for (int d = 0; d < 4; ++d) { o[d] = MFMA32(vf[d][0], pb0, o[d]); o[d] = MFMA32(vf[d][1], pb1, o[d]); }
        if (!__any(carry > 1e-36f)) break;
    }
    asm volatile("s_waitcnt vmcnt(0)" ::: "memory");
    attn_store_o(T, o, 1.0f, Y + (rowbase + t0) * 1024 + h * HD, lane);
}
__device__ __forceinline__ void ca_unit(const bf16_t* __restrict__ QK, const bf16_t* __restrict__ VT, bf16_t* __restrict__ Y, const LAS float* bias, LAS unsigned char* wl, int b, int h, int qb, int lane) {
    const int r32 = lane & 31, hi = lane >> 5, t0 = qb * 32, q = t0 + r32;
    const int ch = qb >> 1; const int kstart = (ch >= 8) ? 64 * (ch - 8) : 0, kend = 64 * (ch + 1);
    const size_t rowbase = (size_t)b * SEQ;
    AttnTile T; attn_tile_init(T, wl, QK + rowbase * QKP + 3072 + h * HD, VT + (size_t)b * (SEQ / 32) * 65536 + (size_t)(1024 + h * HD) * 32, lane);
    const bf16_t* Qp = QK + (rowbase + q) * QKP + 2048 + h * HD + 8 * hi;
    bf16x8 qf[8];
#pragma unroll
    for (int ks = 0; ks < 8; ++ks) qf[ks] = *(const bf16x8*)(Qp + 16 * ks);
    attn_issue_k(T, kstart); attn_issue_v(T, kstart);
    const LAS float* bh = bias + h * NREL;
    f32x16 o[4];
#pragma unroll
    for (int d = 0; d < 4; ++d)
#pragma unroll
        for (int r = 0; r < 16; ++r) o[d][r] = 0.f;
    float mrun = -1e30f, lsum = 0.f;
    for (int sb = kstart; sb < kend; sb += 32) {
        bf16x8 kf[8];
        asm volatile("s_waitcnt vmcnt(8)" ::: "memory");
        attn_read_k(T, kf, lane);
        asm volatile("s_waitcnt lgkmcnt(0)" ::: "memory");
        const bool more = sb + 32 < kend;
        if (more) attn_issue_k(T, sb + 32);
        f32x16 s;
#pragma unroll
        for (int r = 0; r < 16; ++r) s[r] = 0.f;
#pragma unroll
        for (int ks = 0; ks < 8; ++ks) s = MFMA32(kf[ks], qf[ks], s);
        float mx = -1e30f;
        if (sb + 31 - t0 <= -128) {
            const float b0 = bh[0];
#pragma unroll
            for (int r = 0; r < 16; ++r) { s[r] += b0; mx = fmaxf(mx, s[r]); }
        } else {
#pragma unroll
            for (int r = 0; r < 16; ++r) { const int rel = sb + 16 * (r >> 3) + 8 * hi + (r & 7) - q; const int idx = min(max(rel, -128), 63) + 128;
                s[r] += bh[idx]; mx = fmaxf(mx, s[r]); }
        }
        mx = fmaxf(mx, __shfl_xor(mx, 32));
        const float mnew = fmaxf(mrun, mx); const float alpha = __builtin_amdgcn_exp2f(mrun - mnew); mrun = mnew;
        float a[16]; float ps = 0.f;
#pragma unroll
        for (int r = 0; r < 16; ++r) { a[r] = __builtin_amdgcn_exp2f(s[r] - mnew); ps += a[r]; }
        lsum = lsum * alpha + ps;
        if (__any(alpha != 1.0f)) {
#pragma unroll
            for (int d = 0; d < 4; ++d)
#pragma unroll
                for (int r = 0; r < 16; ++r) o[d][r] *= alpha;
        }
        u32x4 p0, p1;
        p0.x = cvtpk(a[0], a[1]); p0.y = cvtpk(a[2], a[3]); p0.z = cvtpk(a[4], a[5]); p0.w = cvtpk(a[6], a[7]);
        p1.x = cvtpk(a[8], a[9]); p1.y = cvtpk(a[10], a[11]); p1.z = cvtpk(a[12], a[13]); p1.w = cvtpk(a[14], a[15]);
        const bf16x8 pb0 = __builtin_bit_cast(bf16x8, p0), pb1 = __builtin_bit_cast(bf16x8, p1);
        bf16x8 vf[4][2];
        if (more) asm volatile("s_waitcnt vmcnt(8)" ::: "memory"); else asm volatile("s_waitcnt vmcnt(0)" ::: "memory");
        attn_read_v(T, vf);
        asm volatile("s_waitcnt lgkmcnt(0)" ::: "memory");
        if (more) attn_issue_v(T, sb + 32);
#pragma unroll
        for (int d = 0; d < 4; ++d) { o[d] = MFMA32(vf[d][0], pb0, o[d]); o[d] = MFMA32(vf[d][1], pb1, o[d]); }
    }
    lsum += __shfl_xor(lsum, 32);
    const float inv = 1.0f / lsum;
    attn_store_o(T, o, inv, Y + (rowbase + t0) * 1024 + h * HD, lane);
}

__device__ __forceinline__ void ca_wg_unit(const bf16_t* __restrict__ QK, const bf16_t* __restrict__ VT, bf16_t* __restrict__ Y, const LAS float* bias, LAS unsigned char* lds, int b, int h, int g, int wave, int lane) {
    constexpr int NS = 4;
    const int r32 = lane & 31, hi = lane >> 5, t0 = 256 * g + 32 * wave, q = t0 + r32;
    const int ch = 4 * g + (wave >> 1);
    const int kmin = (g >= 2) ? 64 * (4 * g - 8) : 0;
    const int ntiles = (64 * (4 * g + 4) - kmin) >> 5;
    const int klo = (ch >= 8) ? 64 * (ch - 8) : 0, khi = 64 * (ch + 1);
    const int tlo = (klo - kmin) >> 5, thi = (khi - kmin) >> 5;
    const size_t rowbase = (size_t)b * SEQ;
    const bf16_t* Qp = QK + (rowbase + q) * QKP + 2048 + h * HD + 8 * hi;
    bf16x8 qf[8];
#pragma unroll
    for (int ks = 0; ks < 8; ++ks) qf[ks] = *(const bf16x8*)(Qp + 16 * ks);
    const int l4 = lane >> 4, c0 = lane & 15, gq = wave & 3, pi_w = (wave & 4) | ((gq == 1) ? 2 : ((gq == 2) ? 1 : gq));
    const bf16_t* ksrc = QK + (rowbase + kmin + 4 * pi_w + l4) * QKP + 3072 + h * HD + ((c0 ^ (4 * gq + l4)) * 8);
    const int vr = lane >> 2, vc = (lane & 3) ^ ((vr >> 2) & 3);
    const bf16_t* vsrc = VT + ((size_t)b * (SEQ / 32) + (kmin >> 5)) * 65536 + (size_t)(1024 + h * HD + 16 * wave + vr) * 32 + vc * 8;
    LAS unsigned char* kdst = lds + wave * 1024; LAS unsigned char* vdst = lds + 8192 + wave * 1024;
#define CAW_ISSUE(tile, slot) do { __builtin_amdgcn_global_load_lds((const unsigned*)(ksrc + (size_t)(tile) * 32 * QKP), (LAS unsigned*)(kdst + (slot) * 16384), 16, 0, 0); \
        __builtin_amdgcn_global_load_lds((const unsigned*)(vsrc + (size_t)(tile) * 65536), (LAS unsigned*)(vdst + (slot) * 16384), 16, 0, 0); } while (0)
    const int kro = r32 * 256, r15 = lane & 15, sw = (r32 >> 2) & 3;
    const int vro0 = 8192 + r32 * 64 + ((hi ^ sw) * 16), vro1 = 8192 + r32 * 64 + (((2 + hi) ^ sw) * 16);
    const LAS float* bh = bias + h * NREL;
    f32x16 o[4];
#pragma unroll
    for (int d = 0; d < 4; ++d)
#pragma unroll
        for (int r = 0; r < 16; ++r) o[d][r] = 0.f;
    float mrun = -1e30f, lsum = 0.f;
    CAW_ISSUE(0, 0); CAW_ISSUE(1, 1); CAW_ISSUE(2, 2);
    for (int tau = 0; tau < ntiles; ++tau) {
        asm volatile("s_waitcnt vmcnt(4) lgkmcnt(0)\n\ts_barrier" ::: "memory");
        { const int nx = (tau + 3 < ntiles) ? tau + 3 : ntiles - 1; const int sl = (tau + 3) & 3; CAW_ISSUE(nx, sl); }
        if (tau >= tlo && tau < thi) {
            const int sb = kmin + 32 * tau;
            LAS unsigned char* wl = lds + (tau & 3) * 16384;
            bf16x8 kf[8];
#pragma unroll
            for (int ks = 0; ks < 8; ++ks) kf[ks] = *(const LAS bf16x8*)(wl + kro + (((2 * ks + hi) ^ r15) * 16));
            f32x16 s;
#pragma unroll
            for (int r = 0; r < 16; ++r) s[r] = 0.f;
#pragma unroll
            for (int ks = 0; ks < 8; ++ks) s = MFMA32(kf[ks], qf[ks], s);
            float mx = -1e30f;
            if (sb + 31 - t0 <= -128) {
                const float b0 = bh[0];
#pragma unroll
                for (int r = 0; r < 16; ++r) { s[r] += b0; mx = fmaxf(mx, s[r]); }
            } else {
#pragma unroll
                for (int r = 0; r < 16; ++r) { const int rel = sb + 16 * (r >> 3) + 8 * hi + (r & 7) - q; const int idx = min(max(rel, -128), 63) + 128;
                    s[r] += bh[idx]; mx = fmaxf(mx, s[r]); }
            }
            mx = fmaxf(mx, __shfl_xor(mx, 32));
            const float mnew = fmaxf(mrun, mx); const float alpha = __builtin_amdgcn_exp2f(mrun - mnew); mrun = mnew;
            float a[16]; float ps = 0.f;
#pragma unroll
            for (int r = 0; r < 16; ++r) { a[r] = __builtin_amdgcn_exp2f(s[r] - mnew); ps += a[r]; }
            lsum = lsum * alpha + ps;
            if (__any(alpha != 1.0f)) {
#pragma unroll
                for (int d = 0; d < 4; ++d)
#pragma unroll
                    for (int r = 0; r < 16; ++r) o[d][r] *= alpha;
            }
            u32x4 p0, p1;
            p0.x = cvtpk(a[0], a[1]); p0.y = cvtpk(a[2], a[3]); p0.z = cvtpk(a[4], a[5]); p0.w = cvtpk(a[6], a[7]);
            p1.x = cvtpk(a[8], a[9]); p1.y = cvtpk(a[10], a[11]); p1.z = cvtpk(a[12], a[13]); p1.w = cvtpk(a[14], a[15]);
            const bf16x8 pb0 = __builtin_bit_cast(bf16x8, p0), pb1 = __builtin_bit_cast(bf16x8, p1);
            bf16x8 vf[4][2];
#pragma unroll
            for (int d = 0; d < 4; ++d) { vf[d][0] = *(const LAS bf16x8*)(wl + vro0 + d * 2048); vf[d][1] = *(const LAS bf16x8*)(wl + vro1 + d * 2048); }
#pragma unroll
            for (int d = 0; d < 4; ++d) { o[d] = MFMA32(vf[d][0], pb0, o[d]); o[d] = MFMA32(vf[d][1], pb1, o[d]); }
        }
    }
#undef CAW_ISSUE
    asm volatile("s_waitcnt vmcnt(0) lgkmcnt(0)\n\ts_barrier" ::: "memory");
    lsum += __shfl_xor(lsum, 32);
    const float inv = 1.0f / lsum;
    AttnTile T; T.wl = lds + 65536 + wave * 8192;
    attn_store_o(T, o, inv, Y + (rowbase + t0) * 1024 + h * HD, lane);
    asm volatile("s_waitcnt vmcnt(0)" ::: "memory");
}

__device__ __forceinline__ int fresh_tid() { int t = threadIdx.x; asm volatile("" : "+v"(t)); return t; }
#define XB_TMO      128
#define XB_XCNT(j)  (256  + 64 * (j))
#define XB_XSUB(j)  (1280 + 64 * (j))
#define XB_XGEN(j)  (2304 + 64 * (j))
#define XB_TOP      3328
#define XB_TOPGEN   3392
#define XCD_BAR_WORDS 3456
#define XB_SPIN_CAP (1u << 18)
__device__ __forceinline__ unsigned xb_ld(unsigned* p)              { return __hip_atomic_load(p, __ATOMIC_RELAXED, __HIP_MEMORY_SCOPE_AGENT); }
__device__ __forceinline__ unsigned xb_add(unsigned* p, unsigned v) { return __hip_atomic_fetch_add(p, v, __ATOMIC_RELAXED, __HIP_MEMORY_SCOPE_AGENT); }
__device__ __forceinline__ unsigned xb_xcc_id() { return (unsigned)__builtin_amdgcn_s_getreg((3 << 11) | 20) & 0xFu; }
#define XB_SPIN(cond, bar) do { unsigned _sp = 0; while (cond) { __builtin_amdgcn_s_sleep(1); \
    if ((++_sp & 255u) == 0u) { if (xb_ld(&(bar)[XB_TMO])) break; if (_sp > XB_SPIN_CAP) { atomicAdd(&(bar)[XB_TMO], 1u); break; } } } } while (0)
struct XcdBarrier { unsigned* bar; unsigned x; volatile LAS unsigned* st; };
__device__ __forceinline__ XcdBarrier xcd_barrier_post(unsigned* bar, volatile LAS unsigned* st) {
    XcdBarrier b; b.bar = bar; b.x = xb_xcc_id(); b.st = st;
    if (fresh_tid() == 0) (void)xb_add(&bar[XB_XCNT(b.x)], 1u);
    return b;
}
__device__ __forceinline__ void xcd_barrier_complete(unsigned* bar, unsigned x, unsigned& nloc, unsigned& nx) {
    const unsigned G = gridDim.x * gridDim.y * gridDim.z;
    unsigned sum, cnt, mine, sp = 0u;
    for (;;) {
        sum = 0u; cnt = 0u; mine = 0u;
#pragma unroll
        for (unsigned j = 0; j < 16; ++j) { const unsigned c = xb_ld(&bar[XB_XCNT(j)]); sum += c; cnt += (c > 0u) ? 1u : 0u; mine = (j == x) ? c : mine; }
        if (sum == G) break;
        __builtin_amdgcn_s_sleep(1);
        if ((++sp & 255u) == 0u) { if (xb_ld(&bar[XB_TMO])) break; if (sp > XB_SPIN_CAP) { atomicAdd(&bar[XB_TMO], 1u); break; } }
    }
    nloc = mine > 0u ? mine : 1u; nx = cnt > 0u ? cnt : 1u;
}
__device__ __forceinline__ void xcd_barrier(const XcdBarrier& b, int wave  ) {
    asm volatile("s_waitcnt vmcnt(0)" ::: "memory");
    __syncthreads();
    if (wave == 0 && __builtin_amdgcn_mbcnt_hi(~0u, __builtin_amdgcn_mbcnt_lo(~0u, 0u)) == 0u) {
        unsigned* bar = b.bar;
        __builtin_amdgcn_s_waitcnt(0);
        unsigned nloc = b.st[0], nx = b.st[1];
        if (nloc == 0u) { xcd_barrier_complete(bar, b.x, nloc, nx); b.st[0] = nloc; b.st[1] = nx; }
        const unsigned old = xb_add(&bar[XB_XSUB(b.x)], 1u);
        const unsigned gen = old / nloc;
        if (old + 1u == (gen + 1u) * nloc) {
            __builtin_amdgcn_fence(__ATOMIC_RELEASE, "agent");
            asm volatile("s_waitcnt vmcnt(0)" ::: "memory");
            const unsigned og = xb_add(&bar[XB_TOP], 1u);
            const unsigned tg = og / nx;
            if (og + 1u == (tg + 1u) * nx) xb_add(&bar[XB_TOPGEN], 1u);
            else XB_SPIN(xb_ld(&bar[XB_TOPGEN]) == tg, bar);
            __builtin_amdgcn_fence(__ATOMIC_ACQUIRE, "agent");
            xb_add(&bar[XB_XGEN(b.x)], 1u);
            asm volatile("s_waitcnt vmcnt(0)" ::: "memory");
        } else {
            XB_SPIN(xb_ld(&bar[XB_XGEN(b.x)]) == gen, bar);
            __builtin_amdgcn_fence(__ATOMIC_ACQUIRE, "agent");
            asm volatile("s_waitcnt vmcnt(0)" ::: "memory");
        }
    }
    __syncthreads();
}

constexpr int NWAVES = 8;
constexpr int LDS_BYTES = 147456;
struct Args { const float* in[15]; float* out; unsigned char* ws; };

__global__ void __launch_bounds__(NWAVES * 64, 2) mega_fwd(Args args) {
    extern __shared__ __attribute__((aligned(16))) unsigned char lds_raw[];
    LAS unsigned char* lds = (LAS unsigned char*)lds_raw;
    cg::grid_group grid = cg::this_grid();
    const int tid = fresh_tid(), lane = tid & 63, wave = __builtin_amdgcn_readfirstlane(tid >> 6);
    const int G = gridDim.x, bx = blockIdx.x;
    const int gw = bx * NWAVES + wave, NGW = G * NWAVES;

    const float* x = args.in[0]; const float* p = args.in[1]; const float* w_in = args.in[2]; const float* w_sb_out = args.in[3]; const float* w_ca_out = args.in[4];
    const float* w_mix_out = args.in[5]; const float* rel_bias = args.in[6]; const float* g_mix = args.in[7]; const float* g_ffn = args.in[8]; const float* g_ple = args.in[9];
    const float* g_final = args.in[10]; const float* w_ffn_in = args.in[11]; const float* w_ffn_out = args.in[12]; const float* w_ple_in = args.in[13]; const float* w_ple_gate = args.in[14];
    unsigned char* ws = args.ws; float* out = args.out;
    bf16_t* WINA = (bf16_t*)(ws + WS_WINA); bf16_t* WINV = (bf16_t*)(ws + WS_WINV); bf16_t* WSB = (bf16_t*)(ws + WS_WSB); bf16_t* WCA = (bf16_t*)(ws + WS_WCA);
    bf16_t* WMIX = (bf16_t*)(ws + WS_WMIX); bf16_t* WFI = (bf16_t*)(ws + WS_WFI); bf16_t* WFO = (bf16_t*)(ws + WS_WFO); bf16_t* WPI = (bf16_t*)(ws + WS_WPI); bf16_t* WPG = (bf16_t*)(ws + WS_WPG);
    bf16_t* PBF = (bf16_t*)(ws + WS_PBF); float* SS = (float*)(ws + WS_SS);
    bf16_t* R1 = (bf16_t*)(ws + WS_R1); bf16_t* GB = (bf16_t*)(ws + WS_G); bf16_t* XN = (bf16_t*)(ws + WS_XN); bf16_t* HB = (bf16_t*)(ws + WS_H);
    bf16_t* QK = (bf16_t*)(ws + WS_QK); bf16_t* TMP = (bf16_t*)(ws + WS_QK); bf16_t* TMP2 = (bf16_t*)(ws + WS_R1);
    bf16_t* VT = (bf16_t*)out; bf16_t* YSB = (bf16_t*)((unsigned char*)out + 64 * MiB); bf16_t* YCA = (bf16_t*)((unsigned char*)out + 96 * MiB);
    float* ss1 = SS; float* ss2 = SS + MTOK; float* ss3 = SS + 2 * MTOK;
    bf16_t* XB = (bf16_t*)(ws + WS_QK + 64 * MiB);
    volatile LAS unsigned* bst = (volatile LAS unsigned*)(lds + LDS_BYTES - 64);
    if (tid < 2) bst[tid] = 0u;
    __syncthreads();
    (void)xcd_barrier_post((unsigned*)(ws + WS_CTL), bst);
#define SEAM() do { XcdBarrier b_; b_.bar = (unsigned*)(ws + WS_CTL); b_.x = xb_xcc_id(); b_.st = bst; xcd_barrier(b_, wave); } while (0)

    for (int rep_ = 0; rep_ < 1 + XP_DUP_P0; ++rep_) {
        LAS float* scr = (LAS float*)(lds + wave * 16640);
        constexpr int I1 = (DM / 64) * (2048 / 64), I2 = (DM / 64) * (1024 / 64), I5 = (DM / 64) * (4096 / 64);
        constexpr int I6 = (1024 / 64) * (DM / 64), I8 = (DM / 64) * (DM / 64), I9 = (DM / 64) * (2 * DFF / 64), I10 = (DFF / 64) * (DM / 64), I11 = (DPLE / 64) * (DM / 64);
        constexpr int NITEMS = I1 + I2 + I1 + I2 + I5 + I6 + I6 + I8 + I9 + I10 + I11 + I8;
        for (int it = gw; it < NITEMS; it += NGW) {
            int r = it;
            if (r < I1) { tr_item(w_in, DM, INCOLS, 0, 2048, WINA, 0, false, g_mix, scr, r, lane); continue; } r -= I1;
            if (r < I2) { tr_item(w_in, DM, INCOLS, 2048, 1024, WINV, 0, false, g_mix, scr, r, lane); continue; } r -= I2;
            if (r < I1) { tr_item(w_in, DM, INCOLS, 3072, 2048, WINA, 2048, false, g_mix, scr, r, lane); continue; } r -= I1;
            if (r < I2) { tr_item(w_in, DM, INCOLS, 5120, 1024, WINV, 1024, false, g_mix, scr, r, lane); continue; } r -= I2;
            if (r < I5) { tr_item(w_in, DM, INCOLS, 6144, 4096, WINA, 4096, false, g_mix, scr, r, lane); continue; } r -= I5;
            if (r < I6) { tr_item(w_sb_out, 1024, DM, 0, DM, WSB, 0, false, nullptr, scr, r, lane); continue; } r -= I6;
            if (r < I6) { tr_item(w_ca_out, 1024, DM, 0, DM, WCA, 0, false, nullptr, scr, r, lane); continue; } r -= I6;
            if (r < I8) { tr_item(w_mix_out, DM, DM, 0, DM, WMIX, 0, false, nullptr, scr, r, lane); continue; } r -= I8;
            if (r < I9) { tr_item(w_ffn_in, DM, 2 * DFF, 0, 2 * DFF, WFI, 0, true, g_ffn, scr, r, lane); continue; } r -= I9;
            if (r < I10) { tr_item(w_ffn_out, DFF, DM, 0, DM, WFO, 0, false, nullptr, scr, r, lane); continue; } r -= I10;
            if (r < I11) { tr_item(w_ple_in, DPLE, DM, 0, DM, WPI, 0, false, nullptr, scr, r, lane); continue; } r -= I11;
            tr_item(w_ple_gate, DM, DM, 0, DM, WPG, 0, false, g_ple, scr, r, lane);
        }
        for (int m = gw; m < MTOK; m += 2 * NGW) {
            const int m1 = (m + NGW < MTOK) ? m + NGW : m;
            const f32x4* xa = (const f32x4*)(x + (size_t)m * DM) + lane; const f32x4* xb = (const f32x4*)(x + (size_t)m1 * DM) + lane;
            f32x4 va[8], vb[8]; float sa = 0.f, sb_ = 0.f;
#pragma unroll
            for (int j = 0; j < 8; ++j) { va[j] = xa[64 * j]; vb[j] = xb[64 * j]; }
#pragma unroll
            for (int j = 0; j < 8; ++j) { sa += (va[j].x * va[j].x + va[j].y * va[j].y) + (va[j].z * va[j].z + va[j].w * va[j].w); sb_ += (vb[j].x * vb[j].x + vb[j].y * vb[j].y) + (vb[j].z * vb[j].z + vb[j].w * vb[j].w); }
            const float ra = 1.0f / sqrtf(wave_sum(sa) * (1.0f / DM) + EPS), rb = 1.0f / sqrtf(wave_sum(sb_) * (1.0f / DM) + EPS);
            u32x2* oa = (u32x2*)(R1 + (size_t)m * DM) + lane; u32x2* ob = (u32x2*)(R1 + (size_t)m1 * DM) + lane;
#pragma unroll
            for (int j = 0; j < 8; ++j) { const f32x4 ya = va[j] * ra, yb = vb[j] * rb; u32x2 wa, wb; wa.x = pg8::cvt_pk_bf16(ya.x, ya.y); wa.y = pg8::cvt_pk_bf16(ya.z, ya.w); wb.x = pg8::cvt_pk_bf16(yb.x, yb.y); wb.y = pg8::cvt_pk_bf16(yb.z, yb.w);
                oa[64 * j] = wa; ob[64 * j] = wb; }
        }
        {
            const size_t n4 = (size_t)MTOK * DPLE / 4; const size_t gt = (size_t)bx * 512 + tid, GT = (size_t)G * 512;
            for (size_t i = gt; i < n4; i += GT) { const f32x4 v = ((const f32x4*)p)[i]; u32x2 w; w.x = pk2(v.x, v.y); w.y = pk2(v.z, v.w); ((u32x2*)PBF)[i] = w; }
            for (size_t i = gt; i < (size_t)3 * MTOK; i += GT) SS[i] = 0.f;
        }
    }
    if (args.ws == nullptr) grid.sync();
    SEAM();

    for (int rep_ = 0; rep_ < 1 + XP_DUP_P1; ++rep_) {
        pg8::Gemm g{R1, WINA, MTOK, 8192, DM}; pg8::StaticOrder S; S.init(MTOK, 8192, G, bx);
        pg8::EpiInProj E{QK, GB};
        pg8::gemm_phase<pg8::EpiInProj, pg8::StaticOrder, true, true, XP_KREP>(lds, g, S, E);
    }
    {
        pg8::Gemm g{WINV, R1, 2048, MTOK, DM}; pg8::StaticOrder S; S.init(2048, MTOK, G, bx);
        pg8::EpiBf16Plain E{VT, MTOK};
        pg8::gemm_phase<pg8::EpiBf16Plain, pg8::StaticOrder, true, true>(lds, g, S, E);
    }
    SEAM();

    for (int xs_ = 0; xs_ < XP_EXTRA_SYNCS; ++xs_) grid.sync();
    for (int rep_ = 0; rep_ < 1 + XP_DUP_P2; ++rep_) {
        int tid2 = threadIdx.x; asm volatile("" : "+v"(tid2)); const int lane = tid2 & 63;
        LAS float* bl = (LAS float*)(lds + 131072 + 1024);
        for (int i = tid2; i < NH * NREL; i += NWAVES * 64) bl[i] = rel_bias[i] * LOG2E;
        __syncthreads();
        const int vcu = (G % 8 == 0) ? (bx % 8) * (G / 8) + bx / 8 : bx;
        for (int i = 0, u = vcu; u < NB * NH * 8; ++i, u += G) { const int bh_ = u >> 3; int g = u & 7; if (i & 1) g = 7 - g;
            ca_wg_unit(QK, VT, YCA, bl, lds, bh_ >> 3, bh_ & 7, g, wave, lane); }
        __syncthreads();
        LAS unsigned char* wl = lds + wave * 16384;
        constexpr int NU = NB * NH * (SEQ / 32);
        for (int u = vcu * NWAVES + wave; u < NU; u += NGW) { const int qb = u & 63, h = (u >> 6) & 7, b = u >> 9; sb_unit(QK, VT, YSB, wl, b, h, qb, lane); }
    }
    SEAM();

    {
        pg8::Gemm g{YSB, WSB, MTOK, DM, 1024}; pg8::StaticOrder S; S.init(MTOK, DM, G, bx);
        pg8::EpiGate<0> E{GB, 0, TMP, R1};
        pg8::gemm_phase<pg8::EpiGate<0>, pg8::StaticOrder, true, true>(lds, g, S, E);
    }
    {
        pg8::Gemm g{YCA, WCA, MTOK, DM, 1024}; pg8::StaticOrder S; S.init(MTOK, DM, G, bx);
        pg8::EpiGate<1> E{GB, 2048, TMP, R1};
        pg8::gemm_phase<pg8::EpiGate<1>, pg8::StaticOrder, true, true>(lds, g, S, E);
    }
    SEAM();

    {
        pg8::Gemm g{R1, WMIX, MTOK, DM, DM}; pg8::StaticOrder S; S.init(MTOK, DM, G, bx);
        pg8::EpiResid<false> E{x, XN, ss1};
        pg8::gemm_phase<pg8::EpiResid<false>, pg8::StaticOrder, true, true>(lds, g, S, E);
    }
    SEAM();

    {
        pg8::Gemm g{XN, WFI, MTOK, 2 * DFF, DM}; pg8::StaticOrder S; S.init(MTOK, 2 * DFF, G, bx);
        pg8::EpiSwiGLU E{HB, ss1};
        pg8::gemm_phase<pg8::EpiSwiGLU, pg8::StaticOrder, true, true>(lds, g, S, E);
    }
    SEAM();

    {
        pg8::Gemm g{HB, WFO, MTOK, DM, DFF}; pg8::StaticOrder S; S.init(MTOK, DM, G, bx);
        pg8::EpiResid<true> E{nullptr, XN, ss2};
        pg8::gemm_phase<pg8::EpiResid<true>, pg8::StaticOrder, true, true>(lds, g, S, E);
    }
    {
        pg8::Gemm g{PBF, WPI, MTOK, DM, DPLE}; pg8::StaticOrder S; S.init(MTOK, DM, G, bx);
        pg8::EpiStoreBf16T E{TMP2};
        pg8::gemm_phase<pg8::EpiStoreBf16T, pg8::StaticOrder, true, true>(lds, g, S, E);
    }
    SEAM();

    {
        pg8::Gemm g{XN, WPG, MTOK, DM, DM}; pg8::StaticOrder S; S.init(MTOK, DM, G, bx);
        pg8::EpiPle E{XN, XB, TMP2, ss2, ss3};
        pg8::gemm_phase<pg8::EpiPle, pg8::StaticOrder, true, true>(lds, g, S, E);
    }
    SEAM();

    int tid8 = threadIdx.x; asm volatile("" : "+v"(tid8)); const int lane8 = tid8 & 63;
    for (int m = gw; m < MTOK; m += 4 * NGW) {
        const f32x4* gr = (const f32x4*)g_final;
        u32x4 w[4][4]; float rs[4];
#pragma unroll
        for (int r = 0; r < 4; ++r) { const int mr = (m + r * NGW < MTOK) ? m + r * NGW : m; const u32x4* xr = (const u32x4*)(XB + (size_t)mr * DM) + lane8;
#pragma unroll
            for (int j = 0; j < 4; ++j) w[r][j] = xr[64 * j];
            rs[r] = ss3[mr]; }
#pragma unroll
        for (int r = 0; r < 4; ++r) rs[r] = 1.0f / sqrtf(rs[r] * (1.0f / DM) + EPS);
#pragma unroll
        for (int j = 0; j < 4; ++j) { const int e = (lane8 + 64 * j) * 2; const f32x4 g0 = gr[e], g1 = gr[e + 1];
#pragma unroll
            for (int r = 0; r < 4; ++r) { if (m + r * NGW < MTOK) { f32x4* o = (f32x4*)(out + (size_t)(m + r * NGW) * DM); f32x4 a, b; pg8::bf8_to_f32(w[r][j], a, b); o[e] = a * rs[r] * g0; o[e + 1] = b * rs[r] * g1; } } }
    }
}

extern "C" void kernel_launch(void* const* d_in, const int* in_sizes, int n_in, void* d_out, int out_size, void* d_ws, size_t ws_size, hipStream_t stream) {
    static int grid = 0;
    if (grid == 0) {
        if (n_in != 15 || out_size != MTOK * DM || ws_size < WS_END) { fprintf(stderr, "kernel_launch: unexpected problem (n_in %d, out %d, ws %zu)\n", n_in, out_size, ws_size); grid = -1; return; }
        int dev = 0, cus = 0, per_cu = 0;
        hipGetDevice(&dev);
        hipDeviceGetAttribute(&cus, hipDeviceAttributeMultiprocessorCount, dev);
        if (hipFuncSetAttribute((const void*)mega_fwd, hipFuncAttributeMaxDynamicSharedMemorySize, LDS_BYTES) != hipSuccess) { fprintf(stderr, "kernel_launch: hipFuncSetAttribute failed\n"); grid = -1; return; }
        if (hipOccupancyMaxActiveBlocksPerMultiprocessor(&per_cu, (const void*)mega_fwd, NWAVES * 64, LDS_BYTES) != hipSuccess || per_cu < 1) { per_cu = 1; (void)hipGetLastError(); }
        grid = cus * per_cu;
    }
    if (grid < 0) return;
    Args a{};
    for (int i = 0; i < 15; ++i) a.in[i] = (const float*)d_in[i];
    a.out = (float*)d_out; a.ws = (unsigned char*)d_ws;
    if (hipMemsetAsync((char*)d_ws + WS_CTL, 0, CTL_BYTES, stream) != hipSuccess) { fprintf(stderr, "kernel_launch: memset failed\n"); return; }
    void* kargs[] = {&a};
    hipError_t e = hipLaunchCooperativeKernel((const void*)mega_fwd, dim3(grid), dim3(NWAVES * 64), kargs, LDS_BYTES, stream);
    if (e != hipSuccess) fprintf(stderr, "cooperative launch failed: %s (grid %d)\n", hipGetErrorString(e), grid);
}
```

```cpp
#include <hip/hip_runtime.h>
#include <hip/hip_cooperative_groups.h>
#include <cstdio>
#include <cstdint>
namespace cg = cooperative_groups;
#ifndef XP_DUP_P0
#define XP_DUP_P0 0
#endif
#ifndef XP_DUP_P2
#define XP_DUP_P2 0
#endif
#ifndef XP_DUP_P1
#define XP_DUP_P1 0
#endif
#ifndef XP_KREP
#define XP_KREP 1
#endif
#ifndef XP_EXTRA_SYNCS
#define XP_EXTRA_SYNCS 0
#endif

#define LAS __attribute__((address_space(3)))
typedef unsigned short bf16_t;
typedef short bf16x8 __attribute__((ext_vector_type(8)));
typedef float f32x4 __attribute__((ext_vector_type(4)));
typedef float f32x16 __attribute__((ext_vector_type(16)));
typedef unsigned u32x4 __attribute__((ext_vector_type(4)));
typedef unsigned u32x2 __attribute__((ext_vector_type(2)));

constexpr int DM = 2048, NB = 8, SEQ = 2048, MTOK = NB * SEQ;
constexpr int NH = 8, HD = 128, DFF = 5632, DPLE = 256, INCOLS = 10240;
constexpr int QKP = 4096;
constexpr int NREL = 192;
constexpr float EPS = 1e-6f;
constexpr float LOG2E = 1.4426950408889634f;
constexpr float QSCALE = 0.08838834764831845f * LOG2E;

constexpr size_t MiB = 1u << 20;
constexpr size_t WS_WINA = 0 * MiB;
constexpr size_t WS_WINV = 32 * MiB;
constexpr size_t WS_WSB = 40 * MiB;
constexpr size_t WS_WCA = 44 * MiB;
constexpr size_t WS_WMIX = 48 * MiB;
constexpr size_t WS_WFI = 56 * MiB;
constexpr size_t WS_WFO = 100 * MiB;
constexpr size_t WS_WPI = 122 * MiB;
constexpr size_t WS_WPG = 123 * MiB;
constexpr size_t WS_PBF = 131 * MiB;
constexpr size_t WS_SS = 139 * MiB;
constexpr size_t WS_CTL = 139 * MiB + 512 * 1024, CTL_BYTES = 16384;
constexpr size_t WS_R1 = 140 * MiB;
constexpr size_t WS_G = 204 * MiB;
constexpr size_t WS_XN = 204 * MiB;
constexpr size_t WS_H = 268 * MiB;
constexpr size_t WS_QK = 332 * MiB;
constexpr size_t WS_END = 460 * MiB;

namespace pg8 {
constexpr int BM = 256, BK = 64, HALF = 128, HTB = HALF * BK * 2, STAGE_BYTES = 8 * HTB, NXCD = 8, WGM = 4;
__host__ __device__ __forceinline__ int lds_byte(int r, int c) { const int st = (r >> 4) * 2 + (c >> 5), rr = r & 15, cc = c & 31, ob = rr * 64 + cc * 2; return st * 1024 + (ob ^ (((ob >> 9) & 1) << 5)); }
__host__ __device__ __forceinline__ void stage_rc(int b, int& R, int& C) { const int st = b / 1024, sb = b % 1024, swz = sb ^ (((sb >> 9) & 1) << 5); R = (st >> 1) * 16 + swz / 64; C = (st & 1) * 32 + (swz % 64) / 2; }
__host__ __device__ __forceinline__ int perm32(int rho) { const int n = rho >> 4, i = rho & 15; return 8 * (i >> 2) + 4 * n + (i & 3); }

struct Unit { int pm, pn; };
struct Gemm { const bf16_t* A; const bf16_t* Bt; int M, N, K; };

struct StaticOrder {
    int nM, nN, nwg, G, c;
    __host__ __device__ void init(int M, int N, int G_, int c_) { nM = M / BM; nN = N / BM; nwg = nM * nN; G = G_; c = c_; }
    __host__ __device__ bool next(int i, Unit& u) const {
        const long L = (long)i * G + c; if (L >= nwg) return false;
        int wgid = (int)L; { const int q = nwg / NXCD, r = nwg % NXCD, xcd = wgid % NXCD, off = wgid / NXCD; wgid = (xcd < r ? xcd * (q + 1) : r * (q + 1) + (xcd - r) * q) + off; }
        const int nig = WGM * nN, gid = wgid / nig, fm = gid * WGM, gsz = (nM - fm) < WGM ? (nM - fm) : WGM;
        u.pm = fm + ((wgid % nig) % gsz); u.pn = (wgid % nig) / gsz; return true;
    }
    __device__ __forceinline__ void a_ready(const Unit&) const {}
    __device__ __forceinline__ void done(const Unit&) const {}
};

__device__ __forceinline__ unsigned cvt_pk_bf16(float lo, float hi) { unsigned r; asm volatile("v_cvt_pk_bf16_f32 %0, %1, %2" : "=v"(r) : "v"(lo), "v"(hi)); return r; }
__device__ __forceinline__ float sigmoidf_(float x) { return __builtin_amdgcn_rcpf(1.0f + __builtin_amdgcn_exp2f(-x * LOG2E)); }
__device__ __forceinline__ float bf2f(unsigned short b) { return __uint_as_float((unsigned)b << 16); }


struct EpiInProj {
    static constexpr bool PERM = true, AFTER_DRAIN = false;
    bf16_t* QK; bf16_t* G;
    __device__ __forceinline__ void operator()(const f32x4 (&acc)[2][2][4][2], const Unit& u, int wr, int wc, int fr, int fq) const {
        const int row0 = u.pm * BM + wr * 64 + fr;
        const bool isg = u.pn >= 16;
        const int pn = isg ? u.pn - 16 : u.pn;
        bf16_t* base = isg ? G : QK;
        const float sc = (((u.pn & 4) == 0) ? QSCALE : 1.0f) * (1.0f / XP_KREP);
        const int col0 = pn * BM + wc * 32 + 8 * fq;
#pragma unroll
        for (int ai = 0; ai < 2; ++ai)
#pragma unroll
            for (int m = 0; m < 4; ++m) { bf16_t* rowp = base + (size_t)(row0 + ai * HALF + m * 16) * QKP + col0;
#pragma unroll
                for (int bj = 0; bj < 2; ++bj) { f32x4 v0 = acc[ai][bj][m][0], v1 = acc[ai][bj][m][1];
                    if (isg) {
#pragma unroll
                        for (int i = 0; i < 4; ++i) { v0[i] = sigmoidf_(v0[i] * (1.0f / XP_KREP)); v1[i] = sigmoidf_(v1[i] * (1.0f / XP_KREP)); }
                    } else { v0 = v0 * sc; v1 = v1 * sc; }
                    u32x4 w; w.x = cvt_pk_bf16(v0[0], v0[1]); w.y = cvt_pk_bf16(v0[2], v0[3]); w.z = cvt_pk_bf16(v1[0], v1[1]); w.w = cvt_pk_bf16(v1[2], v1[3]);
                    *(u32x4*)(rowp + bj * HALF) = w; } }
    }
};
struct EpiBf16Plain {
    static constexpr bool PERM = true, AFTER_DRAIN = false;
    bf16_t* O; int ldc;
    __device__ __forceinline__ void operator()(const f32x4 (&acc)[2][2][4][2], const Unit& u, int wr, int wc, int fr, int fq) const {
        const int row0 = u.pm * BM + wr * 64 + fr;
        const int tb0 = u.pn * 8 + wc;
#pragma unroll
        for (int ai = 0; ai < 2; ++ai)
#pragma unroll
            for (int m = 0; m < 4; ++m) { const int row = row0 + ai * HALF + m * 16;
#pragma unroll
                for (int bj = 0; bj < 2; ++bj) { const f32x4 v0 = acc[ai][bj][m][0], v1 = acc[ai][bj][m][1];
                    u32x4 w; w.x = cvt_pk_bf16(v0[0], v0[1]); w.y = cvt_pk_bf16(v0[2], v0[3]); w.z = cvt_pk_bf16(v1[0], v1[1]); w.w = cvt_pk_bf16(v1[2], v1[3]);
                    *(u32x4*)(O + ((size_t)(tb0 + 4 * bj) * 2048 + row) * 32 + 8 * fq) = w; } }
    }
};
__device__ __forceinline__ void bf8_to_f32(const u32x4 w, f32x4& a, f32x4& b) {
    a[0] = __uint_as_float(w.x << 16); a[1] = __uint_as_float(w.x & 0xffff0000u); a[2] = __uint_as_float(w.y << 16); a[3] = __uint_as_float(w.y & 0xffff0000u);
    b[0] = __uint_as_float(w.z << 16); b[1] = __uint_as_float(w.z & 0xffff0000u); b[2] = __uint_as_float(w.w << 16); b[3] = __uint_as_float(w.w & 0xffff0000u);
}
__device__ __forceinline__ u32x4 f32_to_bf8(const f32x4 a, const f32x4 b) { u32x4 w; w.x = cvt_pk_bf16(a[0], a[1]); w.y = cvt_pk_bf16(a[2], a[3]); w.z = cvt_pk_bf16(b[0], b[1]); w.w = cvt_pk_bf16(b[2], b[3]); return w; }
template <int MODE> struct EpiGate {
    static constexpr bool PERM = true, AFTER_DRAIN = false;
    const bf16_t* G; int goff; bf16_t* TMP; bf16_t* MG;
    __device__ __forceinline__ void operator()(const f32x4 (&acc)[2][2][4][2], const Unit& u, int wr, int wc, int fr, int fq) const {
        const int col0 = u.pn * BM + wc * 32 + 8 * fq;
        u32x4 gw[2][2][2], tw[2][2][2];
#define EG_LOAD(bt, buf) do { _Pragma("unroll") for (int gi = 0; gi < 2; ++gi) { const int ai = ((bt) * 2 + gi) >> 2, m = ((bt) * 2 + gi) & 3; const size_t row = (size_t)(u.pm * BM + ai * HALF + wr * 64 + m * 16 + fr); \
            _Pragma("unroll") for (int bj = 0; bj < 2; ++bj) { const int c = col0 + bj * HALF; gw[buf][gi][bj] = *(const u32x4*)(G + row * QKP + goff + c); if (MODE == 1) tw[buf][gi][bj] = *(const u32x4*)(TMP + row * DM + c); } } } while (0)
        EG_LOAD(0, 0);
#pragma unroll
        for (int bt = 0; bt < 4; ++bt) {
            if (bt + 1 < 4) EG_LOAD(bt + 1, (bt + 1) & 1);
#pragma unroll
            for (int gi = 0; gi < 2; ++gi) { const int ai = (bt * 2 + gi) >> 2, m = (bt * 2 + gi) & 3; const size_t row = (size_t)(u.pm * BM + ai * HALF + wr * 64 + m * 16 + fr);
#pragma unroll
                for (int bj = 0; bj < 2; ++bj) { const int c = col0 + bj * HALF;
                    f32x4 g0, g1; bf8_to_f32(gw[bt & 1][gi][bj], g0, g1);
                    f32x4 v0 = acc[ai][bj][m][0] * g0, v1 = acc[ai][bj][m][1] * g1;
                    if (MODE == 1) { f32x4 t0, t1; bf8_to_f32(tw[bt & 1][gi][bj], t0, t1); v0 = v0 + t0; v1 = v1 + t1; }
                    *(u32x4*)((MODE == 0 ? TMP : MG) + row * DM + c) = f32_to_bf8(v0, v1); } }
            asm volatile("" ::: "memory"); }
#undef EG_LOAD
    }
};
template <bool BASE_BF16> struct EpiResid {
    static constexpr bool PERM = true, AFTER_DRAIN = false;
    const float* basef; bf16_t* X; float* ss;
    __device__ __forceinline__ void operator()(const f32x4 (&acc)[2][2][4][2], const Unit& u, int wr, int wc, int fr, int fq) const {
        const int col0 = u.pn * BM + wc * 32 + 8 * fq;
        f32x4 bsf[2][BASE_BF16 ? 1 : 2][2][2]; u32x4 bsh[2][BASE_BF16 ? 2 : 1][2];
#define ER_LOAD(bt, buf) do { _Pragma("unroll") for (int gi = 0; gi < 2; ++gi) { const int ai = ((bt) * 2 + gi) >> 2, m = ((bt) * 2 + gi) & 3; const size_t row = (size_t)(u.pm * BM + ai * HALF + wr * 64 + m * 16 + fr); \
            _Pragma("unroll") for (int bj = 0; bj < 2; ++bj) { const int c = col0 + bj * HALF; \
                if (BASE_BF16) bsh[buf][BASE_BF16 ? gi : 0][bj] = *(const u32x4*)(X + row * DM + c); \
                else { bsf[buf][BASE_BF16 ? 0 : gi][bj][0] = *(const f32x4*)(basef + row * DM + c); bsf[buf][BASE_BF16 ? 0 : gi][bj][1] = *(const f32x4*)(basef + row * DM + c + 4); } } } } while (0)
        ER_LOAD(0, 0);
#pragma unroll
        for (int bt = 0; bt < 4; ++bt) {
            if (bt + 1 < 4) ER_LOAD(bt + 1, (bt + 1) & 1);
#pragma unroll
            for (int gi = 0; gi < 2; ++gi) { const int ai = (bt * 2 + gi) >> 2, m = (bt * 2 + gi) & 3; const size_t row = (size_t)(u.pm * BM + ai * HALF + wr * 64 + m * 16 + fr); float q = 0.f;
#pragma unroll
                for (int bj = 0; bj < 2; ++bj) { const int c = col0 + bj * HALF;
                    f32x4 b0, b1;
                    if (BASE_BF16) bf8_to_f32(bsh[bt & 1][BASE_BF16 ? gi : 0][bj], b0, b1); else { b0 = bsf[bt & 1][BASE_BF16 ? 0 : gi][bj][0]; b1 = bsf[bt & 1][BASE_BF16 ? 0 : gi][bj][1]; }
                    const f32x4 x0 = b0 + acc[ai][bj][m][0], x1 = b1 + acc[ai][bj][m][1];
                    *(u32x4*)(X + row * DM + c) = f32_to_bf8(x0, x1);
                    q += ((x0[0] * x0[0] + x0[1] * x0[1]) + (x0[2] * x0[2] + x0[3] * x0[3])) + ((x1[0] * x1[0] + x1[1] * x1[1]) + (x1[2] * x1[2] + x1[3] * x1[3])); }
                q += __shfl_xor(q, 16); q += __shfl_xor(q, 32);
                if (fq == 0) __hip_atomic_fetch_add(ss + row, q, __ATOMIC_RELAXED, __HIP_MEMORY_SCOPE_AGENT); }
            asm volatile("" ::: "memory"); }
#undef ER_LOAD
    }
};
struct EpiSwiGLU {
    static constexpr bool PERM = true, AFTER_DRAIN = false;
    bf16_t* H; const float* ss;
    __device__ __forceinline__ void operator()(const f32x4 (&acc)[2][2][4][2], const Unit& u, int wr, int wc, int fr, int fq) const {
        const int col0 = u.pn * HALF + wc * 32 + 8 * fq;
#pragma unroll
        for (int ai = 0; ai < 2; ++ai)
#pragma unroll
            for (int m = 0; m < 4; ++m) { const size_t row = (size_t)(u.pm * BM + ai * HALF + wr * 64 + m * 16 + fr);
                const float rs = __builtin_amdgcn_rsqf(ss[row] * (1.0f / DM) + EPS);
                float o[8];
#pragma unroll
                for (int n = 0; n < 2; ++n)
#pragma unroll
                    for (int i = 0; i < 4; ++i) { const float g = acc[ai][0][m][n][i] * rs, uu = acc[ai][1][m][n][i] * rs; o[n * 4 + i] = g * sigmoidf_(g) * uu; }
                u32x4 w; w.x = cvt_pk_bf16(o[0], o[1]); w.y = cvt_pk_bf16(o[2], o[3]); w.z = cvt_pk_bf16(o[4], o[5]); w.w = cvt_pk_bf16(o[6], o[7]);
                *(u32x4*)(H + row * DFF + col0) = w; }
    }
};
struct EpiStoreBf16T {
    static constexpr bool PERM = false, AFTER_DRAIN = false;
    bf16_t* TMP;
    __device__ __forceinline__ void operator()(const f32x4 (&acc)[2][2][4][2], const Unit& u, int wr, int wc, int fr, int fq) const {
        const int col0 = u.pn * BM + wc * 32 + 4 * fq;
#pragma unroll
        for (int ai = 0; ai < 2; ++ai)
#pragma unroll
            for (int m = 0; m < 4; ++m) { const size_t row = (size_t)(u.pm * BM + ai * HALF + wr * 64 + m * 16 + fr);
#pragma unroll
                for (int bj = 0; bj < 2; ++bj)
#pragma unroll
                    for (int n = 0; n < 2; ++n) { const f32x4 v = acc[ai][bj][m][n]; u32x2 w; w.x = cvt_pk_bf16(v[0], v[1]); w.y = cvt_pk_bf16(v[2], v[3]);
                        *(u32x2*)(TMP + row * DM + col0 + bj * HALF + n * 16) = w; } }
    }
};
struct EpiPle {
    static constexpr bool PERM = true, AFTER_DRAIN = false;
    const bf16_t* X; bf16_t* XB; const bf16_t* TMP; const float* ssin; float* ssout;
    __device__ __forceinline__ void operator()(const f32x4 (&acc)[2][2][4][2], const Unit& u, int wr, int wc, int fr, int fq) const {
        const int col0 = u.pn * BM + wc * 32 + 8 * fq;
#pragma unroll
        for (int ai = 0; ai < 2; ++ai)
#pragma unroll
            for (int mp = 0; mp < 2; ++mp) {
                u32x4 xs[2][2]; u32x4 tw[2][2]; float sv[2];
#pragma unroll
                for (int mm = 0; mm < 2; ++mm) { const int m = mp * 2 + mm; const size_t row = (size_t)(u.pm * BM + ai * HALF + wr * 64 + m * 16 + fr);
                    sv[mm] = ssin[row];
#pragma unroll
                    for (int bj = 0; bj < 2; ++bj) { const int c = col0 + bj * HALF; xs[mm][bj] = *(const u32x4*)(X + row * DM + c); tw[mm][bj] = *(const u32x4*)(TMP + row * DM + c); } }
#pragma unroll
                for (int mm = 0; mm < 2; ++mm) { const int m = mp * 2 + mm; const size_t row = (size_t)(u.pm * BM + ai * HALF + wr * 64 + m * 16 + fr); float q = 0.f;
                    const float rs = __builtin_amdgcn_rsqf(sv[mm] * (1.0f / DM) + EPS);
#pragma unroll
                    for (int bj = 0; bj < 2; ++bj) { const int c = col0 + bj * HALF;
                        f32x4 t0, t1, x0, x1; bf8_to_f32(tw[mm][bj], t0, t1); bf8_to_f32(xs[mm][bj], x0, x1);
                        const f32x4 a0 = acc[ai][bj][m][0], a1 = acc[ai][bj][m][1];
#pragma unroll
                        for (int i = 0; i < 4; ++i) { x0[i] += sigmoidf_(a0[i] * rs) * t0[i]; x1[i] += sigmoidf_(a1[i] * rs) * t1[i]; }
                        *(u32x4*)(XB + row * DM + c) = f32_to_bf8(x0, x1);
                        q += ((x0[0] * x0[0] + x0[1] * x0[1]) + (x0[2] * x0[2] + x0[3] * x0[3])) + ((x1[0] * x1[0] + x1[1] * x1[1]) + (x1[2] * x1[2] + x1[3] * x1[3])); }
                    q += __shfl_xor(q, 16); q += __shfl_xor(q, 32);
                    if (fq == 0) __hip_atomic_fetch_add(ssout + row, q, __ATOMIC_RELAXED, __HIP_MEMORY_SCOPE_AGENT); }
                asm volatile("" ::: "memory"); }
    }
};

template <class Epi, class Sched, bool ALIGN_EPI = false, bool SP2 = false, int KREP = 1>
__device__ __forceinline__ void gemm_phase(LAS unsigned char* lds, const Gemm g, const Sched& S, const Epi& E) {
    int tid_ = threadIdx.x; asm volatile("" : "+v"(tid_));
    const int tid = tid_, wid = __builtin_amdgcn_readfirstlane(tid >> 6), lane = tid & 63, wr = wid >> 2, wc = wid & 3, fr = lane & 15, fq = lane >> 4;
    const int K = g.K, nt = K / BK;
    unsigned voffA[2], voffB[2];
#pragma unroll
    for (int i = 0; i < 2; ++i) { int R, C; stage_rc(tid * 16 + i * 8192, R, C); const int Rb = Epi::PERM ? ((R & ~31) + perm32(R & 31)) : R;
        voffA[i] = (unsigned)(R * K + C) * 2u; voffB[i] = (unsigned)(Rb * K + C) * 2u; }
    const size_t kstep = (size_t)(BK * 2);
    const size_t hstep = (size_t)HALF * K * 2;
    const size_t tstep = 2 * hstep;
    const unsigned ldsw = (unsigned)wid * 1024u;
    const int aoff = lds_byte(wr * 64 + fr, fq * 8), boff = lds_byte(wc * 32 + fr, fq * 8);
#define PG8_SA(b, h) (((b) * 2 + (h)) * HTB)
#define PG8_SB(b, h) ((4 + (b) * 2 + (h)) * HTB)
#define PG8_STAGE(bufoff, gbase, voff) do { _Pragma("unroll") for (int _i = 0; _i < 2; ++_i) \
        __builtin_amdgcn_global_load_lds((const unsigned*)((const char*)(gbase) + (voff)[_i]), (LAS unsigned*)(lds + (bufoff) + ldsw + _i * 8192), 16, 0, 0); } while (0)
#define PG8_LDA(dst, b, h) do { _Pragma("unroll") for (int m = 0; m < 4; ++m) _Pragma("unroll") for (int k = 0; k < 2; ++k) dst[m][k] = *(const LAS bf16x8*)(lds + PG8_SA(b, h) + aoff + m * 2048 + k * 1024); } while (0)
#define PG8_LDB(dst, b, h) do { _Pragma("unroll") for (int n = 0; n < 2; ++n) _Pragma("unroll") for (int k = 0; k < 2; ++k) dst[n][k] = *(const LAS bf16x8*)(lds + PG8_SB(b, h) + boff + n * 2048 + k * 1024); } while (0)
#define PG8_MMA(ai, bj, At, Bt) do { __builtin_amdgcn_s_setprio(1); _Pragma("unroll") for (int m = 0; m < 4; ++m) _Pragma("unroll") for (int n = 0; n < 2; ++n) _Pragma("unroll") for (int k = 0; k < 2; ++k) \
        acc[ai][bj][m][n] = __builtin_amdgcn_mfma_f32_16x16x32_bf16(Bt[n][k], At[m][k], acc[ai][bj][m][n], 0, 0, 0); __builtin_amdgcn_s_setprio(0); } while (0)
#define PG8_WAIT_V(n) asm volatile("s_waitcnt vmcnt(" #n ")" ::: "memory")
#define PG8_WAIT_L(n) asm volatile("s_waitcnt lgkmcnt(" #n ")" ::: "memory")
#define PG8_BAR __builtin_amdgcn_s_barrier()
#define PG8_SCHED __builtin_amdgcn_sched_barrier(0)
    Unit cur, nxt; int ui = 0;
    if (!S.next(0, cur)) return;
    f32x4 acc[2][2][4][2];
#pragma unroll
    for (int a = 0; a < 2; ++a)
#pragma unroll
        for (int b = 0; b < 2; ++b)
#pragma unroll
            for (int m = 0; m < 4; ++m)
#pragma unroll
                for (int n = 0; n < 2; ++n) acc[a][b][m][n] = (f32x4){0.f, 0.f, 0.f, 0.f};
    bf16x8 At[4][2], B0[2][2], B1[2][2];
    const char* cA = (const char*)g.A + (size_t)cur.pm * tstep; const char* cB = (const char*)g.Bt + (size_t)cur.pn * tstep;
    S.a_ready(cur);
    if constexpr (SP2) {
        PG8_STAGE(PG8_SB(0, 0), cB, voffB); PG8_STAGE(PG8_SB(0, 1), cB + hstep, voffB); PG8_STAGE(PG8_SA(0, 0), cA, voffA); PG8_STAGE(PG8_SA(0, 1), cA + hstep, voffA);
        if (wr == 1) PG8_BAR;
        PG8_WAIT_V(2); PG8_BAR;
        PG8_STAGE(PG8_SB(1, 0), cB + kstep, voffB); PG8_STAGE(PG8_SA(1, 0), cA + kstep, voffA); PG8_STAGE(PG8_SB(1, 1), cB + hstep + kstep, voffB);
        PG8_WAIT_V(6); PG8_BAR;
    } else {
        PG8_STAGE(PG8_SB(0, 0), cB, voffB); PG8_STAGE(PG8_SA(0, 0), cA, voffA); PG8_STAGE(PG8_SB(0, 1), cB + hstep, voffB); PG8_STAGE(PG8_SA(0, 1), cA + hstep, voffA);
        if (wr == 1) PG8_BAR;
        PG8_WAIT_V(4); PG8_BAR;
        PG8_STAGE(PG8_SB(1, 0), cB + kstep, voffB); PG8_STAGE(PG8_SA(1, 0), cA + kstep, voffA); PG8_STAGE(PG8_SB(1, 1), cB + hstep + kstep, voffB);
        PG8_WAIT_V(6); PG8_BAR;
    }
    for (;;) {
        const bool has_next = S.next(ui + 1, nxt);
        const char* nA = has_next ? (const char*)g.A + (size_t)nxt.pm * tstep : cA; const char* nB = has_next ? (const char*)g.Bt + (size_t)nxt.pn * tstep : cB;
        for (int t = 0; t < nt * KREP; t += 2) {
            const bool last = (t == nt * KREP - 2);
            const int t1 = (KREP == 1) ? t + 1 : ((t + 1) & (nt - 1)), t2 = (KREP == 1) ? t + 2 : ((t + 2) & (nt - 1));
            const char* a1 = cA + (size_t)t1 * kstep;
            const char* a2 = last ? nA : cA + (size_t)t2 * kstep; const char* b2 = last ? nB : cB + (size_t)t2 * kstep;
            const char* a3 = a2 + kstep; const char* b3 = b2 + kstep;
            if (last && has_next) S.a_ready(nxt);
            if constexpr (SP2) {
            PG8_LDB(B0, 0, 0); PG8_LDB(B1, 0, 1); PG8_SCHED; PG8_LDA(At, 0, 0); PG8_STAGE(PG8_SA(1, 1), a1 + hstep, voffA);
            PG8_WAIT_V(8); PG8_WAIT_L(0); PG8_BAR; PG8_MMA(0, 0, At, B0); PG8_MMA(0, 1, At, B1); PG8_BAR; PG8_SCHED;
            PG8_LDA(At, 0, 1); PG8_STAGE(PG8_SB(0, 0), b2, voffB); PG8_STAGE(PG8_SB(0, 1), b2 + hstep, voffB); PG8_STAGE(PG8_SA(0, 0), a2, voffA);
            PG8_WAIT_V(8); PG8_WAIT_L(0); PG8_BAR; PG8_MMA(1, 0, At, B0); PG8_MMA(1, 1, At, B1); PG8_BAR; PG8_SCHED;
            PG8_LDB(B0, 1, 0); PG8_LDB(B1, 1, 1); PG8_SCHED; PG8_LDA(At, 1, 0); PG8_STAGE(PG8_SA(0, 1), a2 + hstep, voffA);
            PG8_WAIT_V(8); PG8_WAIT_L(0); PG8_BAR; PG8_MMA(0, 0, At, B0); PG8_MMA(0, 1, At, B1); PG8_BAR; PG8_SCHED;
            PG8_LDA(At, 1, 1); PG8_STAGE(PG8_SB(1, 0), b3, voffB); PG8_STAGE(PG8_SB(1, 1), b3 + hstep, voffB); PG8_STAGE(PG8_SA(1, 0), a3, voffA);
            PG8_WAIT_V(8); PG8_WAIT_L(0); PG8_BAR; PG8_MMA(1, 0, At, B0); PG8_MMA(1, 1, At, B1); PG8_BAR; PG8_SCHED;
            } else {
            PG8_LDB(B0, 0, 0); PG8_SCHED; PG8_LDA(At, 0, 0); PG8_STAGE(PG8_SA(1, 1), a1 + hstep, voffA);
            PG8_WAIT_L(8); PG8_BAR; PG8_WAIT_L(0); PG8_MMA(0, 0, At, B0); PG8_BAR; PG8_SCHED;
            PG8_LDB(B1, 0, 1); PG8_STAGE(PG8_SB(0, 0), b2, voffB);
            PG8_BAR; PG8_WAIT_L(0); PG8_MMA(0, 1, At, B1); PG8_BAR;
            PG8_LDA(At, 0, 1); PG8_STAGE(PG8_SA(0, 0), a2, voffA);
            PG8_BAR; PG8_WAIT_L(0); PG8_MMA(1, 0, At, B0); PG8_BAR; PG8_SCHED;
            PG8_STAGE(PG8_SB(0, 1), b2 + hstep, voffB);
            PG8_WAIT_V(6); PG8_BAR; PG8_MMA(1, 1, At, B1); PG8_BAR;
            PG8_LDB(B0, 1, 0); PG8_SCHED; PG8_LDA(At, 1, 0); PG8_STAGE(PG8_SA(0, 1), a2 + hstep, voffA);
            PG8_WAIT_L(8); PG8_BAR; PG8_WAIT_L(0); PG8_MMA(0, 0, At, B0); PG8_BAR; PG8_SCHED;
            PG8_LDB(B1, 1, 1); PG8_STAGE(PG8_SB(1, 0), b3, voffB);
            PG8_BAR; PG8_WAIT_L(0); PG8_MMA(0, 1, At, B1); PG8_BAR;
            PG8_LDA(At, 1, 1); PG8_STAGE(PG8_SA(1, 0), a3, voffA);
            PG8_BAR; PG8_WAIT_L(0); PG8_MMA(1, 0, At, B0); PG8_BAR; PG8_SCHED;
            PG8_STAGE(PG8_SB(1, 1), b3 + hstep, voffB);
            PG8_WAIT_V(6); PG8_BAR; PG8_MMA(1, 1, At, B1); PG8_BAR;
            }
        }
        if constexpr (ALIGN_EPI) { if (wr == 0) PG8_BAR; }
        if constexpr (!Epi::AFTER_DRAIN) { E(acc, cur, wr, wc, fr, fq); S.done(cur); }
        if (!has_next) break;
#pragma unroll
        for (int a = 0; a < 2; ++a)
#pragma unroll
            for (int b = 0; b < 2; ++b)
#pragma unroll
                for (int m = 0; m < 4; ++m)
#pragma unroll
                    for (int n = 0; n < 2; ++n) acc[a][b][m][n] = (f32x4){0.f, 0.f, 0.f, 0.f};
        cur = nxt; cA = nA; cB = nB; ++ui;
        if constexpr (ALIGN_EPI) { if (wr == 1) PG8_BAR; }
    }
    PG8_WAIT_V(0);
    if constexpr (!ALIGN_EPI) { if (wr == 0) PG8_BAR; }
    PG8_BAR;
#undef PG8_SA
#undef PG8_SB
#undef PG8_STAGE
#undef PG8_LDA
#undef PG8_LDB
#undef PG8_MMA
#undef PG8_WAIT_V
#undef PG8_WAIT_L
#undef PG8_BAR
#undef PG8_SCHED
}
}

__device__ __forceinline__ unsigned f2bf(float f) { unsigned u = __builtin_bit_cast(unsigned, f); return (u + 0x7fffu + ((u >> 16) & 1u)) >> 16; }
__device__ __forceinline__ unsigned pk2(float lo, float hi) { return f2bf(lo) | (f2bf(hi) << 16); }
__device__ __forceinline__ float wave_sum(float v) {
#pragma unroll
    for (int o = 1; o < 64; o <<= 1) v += __shfl_xor(v, o);
    return v;
}
__device__ __forceinline__ void tr_item(const float* W, int K, int ldw, int col0, int ncols, bf16_t* WT, int dst_row0, bool ffmap, const float* gain  , LAS float* scr, int item, int lane) {
    const int nblk = ncols / 64, kb = item / nblk, nb = item % nblk, k0 = 64 * kb, n0 = 64 * nb;
    const int kr = lane >> 4, nc = lane & 15;
    const float* src = W + (size_t)(k0 + kr) * ldw + col0 + n0 + 4 * nc;
    f32x4 v[16];
#pragma unroll
    for (int i = 0; i < 16; ++i) v[i] = *(const f32x4*)(src + (size_t)(4 * i) * ldw);
    if (gain) {
#pragma unroll
        for (int i = 0; i < 16; ++i) v[i] = v[i] * gain[k0 + 4 * i + kr];
    }
#pragma unroll
    for (int i = 0; i < 16; ++i) { LAS float* d = scr + (4 * i + kr) * 65 + 4 * nc; d[0] = v[i].x; d[1] = v[i].y; d[2] = v[i].z; d[3] = v[i].w; }
    asm volatile("s_waitcnt lgkmcnt(0)" ::: "memory");
    int rbase;
    if (ffmap) { int j = n0; int isu = 0; if (j >= DFF) { j -= DFF; isu = 128; } rbase = 256 * (j >> 7) + isu + (j & 127); }
    else rbase = dst_row0 + n0;
    const int c = lane & 7;
#pragma unroll
    for (int j = 0; j < 8; ++j) { const int n = (lane >> 3) + 8 * j; const LAS float* sp = scr + (8 * c) * 65 + n;
        u32x4 o; o.x = pg8::cvt_pk_bf16(sp[0 * 65], sp[1 * 65]); o.y = pg8::cvt_pk_bf16(sp[2 * 65], sp[3 * 65]); o.z = pg8::cvt_pk_bf16(sp[4 * 65], sp[5 * 65]); o.w = pg8::cvt_pk_bf16(sp[6 * 65], sp[7 * 65]);
        *(u32x4*)(WT + (size_t)(rbase + n) * K + k0 + 8 * c) = o; }
    asm volatile("s_waitcnt lgkmcnt(0)" ::: "memory");
}
__device__ __forceinline__ void x_row_to_bf16(const float* xrow, bf16_t* orow, int lane) {
    const f32x4* xr = (const f32x4*)xrow + lane;
    f32x4 v[8]; float s = 0.f;
#pragma unroll
    for (int j = 0; j < 8; ++j) { v[j] = xr[64 * j]; s += (v[j].x * v[j].x + v[j].y * v[j].y) + (v[j].z * v[j].z + v[j].w * v[j].w); }
    const float rs = 1.0f / sqrtf(wave_sum(s) * (1.0f / DM) + EPS);
    u32x2* o8 = (u32x2*)orow + lane;
#pragma unroll
    for (int j = 0; j < 8; ++j) { const f32x4 y = v[j] * rs; u32x2 w; w.x = pg8::cvt_pk_bf16(y.x, y.y); w.y = pg8::cvt_pk_bf16(y.z, y.w); o8[64 * j] = w; }
}

__device__ __forceinline__ int pi32(int i) { const int g = (i >> 2) & 3; const int g2 = (g == 1) ? 2 : ((g == 2) ? 1 : g); return (i & 16) | (g2 << 2) | (i & 3); }
__device__ __forceinline__ unsigned cvtpk(float lo, float hi) { unsigned r; asm volatile("v_cvt_pk_bf16_f32 %0, %1, %2" : "=v"(r) : "v"(lo), "v"(hi)); return r; }
#define MFMA32(a, b, c) __builtin_amdgcn_mfma_f32_32x32x16_bf16((a), (b), (c), 0, 0, 0)

struct AttnTile {
    LAS unsigned char* wl;
    const bf16_t* kb; const bf16_t* vb;
    unsigned kgo[4];
    unsigned vgo;
    int kro, vro0, vro1;
};
__device__ __forceinline__ void attn_tile_init(AttnTile& T, LAS unsigned char* wl, const bf16_t* Kbase  , const bf16_t* Vbase  , int lane) {
    T.wl = wl; T.kb = Kbase; T.vb = Vbase;
    const int l4 = lane >> 4, c0 = lane & 15;
#pragma unroll
    for (int g = 0; g < 4; ++g) T.kgo[g] = (unsigned)(l4 * QKP + ((c0 ^ (4 * g + l4)) * 8));
    const int vr = lane >> 2, vc = (lane & 3) ^ ((vr >> 2) & 3);
    T.vgo = (unsigned)(vr * 32 + vc * 8);
    const int r32 = lane & 31, hi = lane >> 5, sw = (r32 >> 2) & 3;
    T.kro = r32 * 256;
    T.vro0 = 8192 + r32 * 64 + ((hi ^ sw) * 16);
    T.vro1 = 8192 + r32 * 64 + (((2 + hi) ^ sw) * 16);
}
__device__ __forceinline__ void attn_issue_k(const AttnTile& T, int sb) {
#pragma unroll
    for (int i = 0; i < 8; ++i) { const int g = i & 3; const int pi_i = (i & 4) | ((g == 1) ? 2 : ((g == 2) ? 1 : g));
        __builtin_amdgcn_global_load_lds((const unsigned*)(T.kb + (size_t)(sb + 4 * pi_i) * QKP + T.kgo[g]), (LAS unsigned*)(T.wl + i * 1024), 16, 0, 0); }
}
__device__ __forceinline__ void attn_issue_v(const AttnTile& T, int sb) {
#pragma unroll
    for (int i = 0; i < 8; ++i)
        __builtin_amdgcn_global_load_lds((const unsigned*)(T.vb + (size_t)(sb >> 5) * 65536 + (16 * i) * 32 + T.vgo), (LAS unsigned*)(T.wl + 8192 + i * 1024), 16, 0, 0);
}
__device__ __forceinline__ void attn_read_k(const AttnTile& T, bf16x8 (&kf)[8], int lane) {
    const int r15 = lane & 15, hi = lane >> 5;
#pragma unroll
    for (int ks = 0; ks < 8; ++ks) kf[ks] = *(const LAS bf16x8*)(T.wl + T.kro + (((2 * ks + hi) ^ r15) * 16));
}
__device__ __forceinline__ void attn_read_v(const AttnTile& T, bf16x8 (&vf)[4][2]) {
#pragma unroll
    for (int d = 0; d < 4; ++d) { vf[d][0] = *(const LAS bf16x8*)(T.wl + T.vro0 + d * 2048); vf[d][1] = *(const LAS bf16x8*)(T.wl + T.vro1 + d * 2048); }
}
__device__ __forceinline__ void attn_store_o(const AttnTile& T, const f32x16 (&o)[4], float scale, bf16_t* Yrow0  , int lane) {
    const int r32 = lane & 31, hi = lane >> 5;
#pragma unroll
    for (int d = 0; d < 4; ++d)
#pragma unroll
        for (int g = 0; g < 4; ++g) { u32x2 w; w.x = cvtpk(o[d][4 * g] * scale, o[d][4 * g + 1] * scale); w.y = cvtpk(o[d][4 * g + 2] * scale, o[d][4 * g + 3] * scale);
            *(LAS u32x2*)(T.wl + r32 * 256 + (((4 * d + g) ^ (r32 & 15)) * 16) + hi * 8) = w; }
    asm volatile("s_waitcnt lgkmcnt(0)" ::: "memory");
    const int l4 = lane >> 4, cs = lane & 15;
#pragma unroll
    for (int i = 0; i < 8; ++i) { const int row = 4 * i + l4; const u32x4 v = *(const LAS u32x4*)(T.wl + row * 256 + cs * 16);
        *(u32x4*)(Yrow0 + (size_t)row * 1024 + ((cs ^ (row & 15)) * 8)) = v; }
    asm volatile("s_waitcnt lgkmcnt(0)" ::: "memory");
}

__device__ __forceinline__ void sb_unit(const bf16_t* __restrict__ QK, const bf16_t* __restrict__ VT, bf16_t* __restrict__ Y, LAS unsigned char* wl, int b, int h, int qb, int lane) {
    const int r32 = lane & 31, hi = lane >> 5, t0 = qb * 32, q = t0 + r32;
    const size_t rowbase = (size_t)b * SEQ;
    AttnTile T; attn_tile_init(T, wl, QK + rowbase * QKP + 1024 + h * HD, VT + (size_t)b * (SEQ / 32) * 65536 + (size_t)(h * HD) * 32, lane);
    const bf16_t* Qp = QK + (rowbase + q) * QKP + h * HD + 8 * hi;
    bf16x8 qf[8];
#pragma unroll
    for (int ks = 0; ks < 8; ++ks) qf[ks] = *(const bf16x8*)(Qp + 16 * ks);
    attn_issue_k(T, t0); attn_issue_v(T, t0);
    f32x16 o[4];
#pragma unroll
    for (int d = 0; d < 4; ++d)
#pragma unroll
        for (int r = 0; r < 16; ++r) o[d][r] = 0.f;
    float carry = 1.0f;
    for (int sb = t0; sb >= 0; sb -= 32) {
        bf16x8 kf[8];
        asm volatile("s_waitcnt vmcnt(8)" ::: "memory");
        attn_read_k(T, kf, lane);
        asm volatile("s_waitcnt lgkmcnt(0)" ::: "memory");
        const bool more = sb > 0;
        if (more) attn_issue_k(T, sb - 32);
        f32x16 s;
#pragma unroll
        for (int r = 0; r < 16; ++r) s[r] = 0.f;
#pragma unroll
        for (int ks = 0; ks < 8; ++ks) s = MFMA32(kf[ks], qf[ks], s);
        float u[16];
#pragma unroll
        for (int r = 0; r < 16; ++r) u[r] = __builtin_amdgcn_rcpf(1.0f + __builtin_amdgcn_exp2f(s[r]));
        if (sb == t0) {
#pragma unroll
            for (int r = 0; r < 16; ++r) { const int key = sb + 16 * (r >> 3) + 8 * hi + (r & 7); u[r] = (key < q) ? u[r] : 1.0f; }
        }
        float S[16];
        S[7] = u[7]; S[15] = u[15];
#pragma unroll
        for (int r = 6; r >= 0; --r) { S[r] = u[r] * S[r + 1]; S[r + 8] = u[r + 8] * S[r + 9]; }
        const float TA = S[0], TB = S[8];
        const float pTA = __shfl_xor(TA, 32), pTB = __shfl_xor(TB, 32);
        const float offB = hi ? carry : carry * pTB;
        const float offA = (carry * TB) * (hi ? pTB : pTB * pTA);
        float a[16];
#pragma unroll
        for (int r = 0; r < 16; ++r) { const float ex = ((r & 7) == 7) ? 1.0f : S[r + 1]; a[r] = (1.0f - u[r]) * (ex * ((r < 8) ? offA : offB)); }
        carry *= (TA * TB) * (pTA * pTB);
        u32x4 p0, p1;
        p0.x = cvtpk(a[0], a[1]); p0.y = cvtpk(a[2], a[3]); p0.z = cvtpk(a[4], a[5]); p0.w = cvtpk(a[6], a[7]);
        p1.x = cvtpk(a[8], a[9]); p1.y = cvtpk(a[10], a[11]); p1.z = cvtpk(a[12], a[13]); p1.w = cvtpk(a[14], a[15]);
        const bf16x8 pb0 = __builtin_bit_cast(bf16x8, p0), pb1 = __builtin_bit_cast(bf16x8, p1);
        bf16x8 vf[4][2];
        if (more) asm volatile("s_waitcnt vmcnt(8)" ::: "memory"); else asm volatile("s_waitcnt vmcnt(0)" ::: "memory");
        attn_read_v(T, vf);
        asm volatile("s_waitcnt lgkmcnt(0)" ::: "memory");
        if (more) attn_issue_v(T, sb - 32);
#pragma unroll
        for (int d = 0; d < 4; ++d) { o[d] = MFMA32(vf[d][0], pb0, o[d]); o[d] = MFMA32(vf[d][1], pb1, o[d]); }
        if (!__any(carry > 1e-36f)) break;
    }
    asm volatile("s_waitcnt vmcnt(0)" ::: "memory");
    attn_store_o(T, o, 1.0f, Y + (rowbase + t0) * 1024 + h * HD, lane);
}
__device__ __forceinline__ void ca_unit(const bf16_t* __restrict__ QK, const bf16_t* __restrict__ VT, bf16_t* __restrict__ Y, const LAS float* bias, LAS unsigned char* wl, int b, int h, int qb, int lane) {
    const int r32 = lane & 31, hi = lane >> 5, t0 = qb * 32, q = t0 + r32;
    const int ch = qb >> 1; const int kstart = (ch >= 8) ? 64 * (ch - 8) : 0, kend = 64 * (ch + 1);
    const size_t rowbase = (size_t)b * SEQ;
    AttnTile T; attn_tile_init(T, wl, QK + rowbase * QKP + 3072 + h * HD, VT + (size_t)b * (SEQ / 32) * 65536 + (size_t)(1024 + h * HD) * 32, lane);
    const bf16_t* Qp = QK + (rowbase + q) * QKP + 2048 + h * HD + 8 * hi;
    bf16x8 qf[8];
#pragma unroll
    for (int ks = 0; ks < 8; ++ks) qf[ks] = *(const bf16x8*)(Qp + 16 * ks);
    attn_issue_k(T, kstart); attn_issue_v(T, kstart);
    const LAS float* bh = bias + h * NREL;
    f32x16 o[4];
#pragma unroll
    for (int d = 0; d < 4; ++d)
#pragma unroll
        for (int r = 0; r < 16; ++r) o[d][r] = 0.f;
    float mrun = -1e30f, lsum = 0.f;
    for (int sb = kstart; sb < kend; sb += 32) {
        bf16x8 kf[8];
        asm volatile("s_waitcnt vmcnt(8)" ::: "memory");
        attn_read_k(T, kf, lane);
        asm volatile("s_waitcnt lgkmcnt(0)" ::: "memory");
        const bool more = sb + 32 < kend;
        if (more) attn_issue_k(T, sb + 32);
        f32x16 s;
#pragma unroll
        for (int r = 0; r < 16; ++r) s[r] = 0.f;
#pragma unroll
        for (int ks = 0; ks < 8; ++ks) s = MFMA32(kf[ks], qf[ks], s);
        float mx = -1e30f;
        if (sb + 31 - t0 <= -128) {
            const float b0 = bh[0];
#pragma unroll
            for (int r = 0; r < 16; ++r) { s[r] += b0; mx = fmaxf(mx, s[r]); }
        } else {
#pragma unroll
            for (int r = 0; r < 16; ++r) { const int rel = sb + 16 * (r >> 3) + 8 * hi + (r & 7) - q; const int idx = min(max(rel, -128), 63) + 128;
                s[r] += bh[idx]; mx = fmaxf(mx, s[r]); }
        }
        mx = fmaxf(mx, __shfl_xor(mx, 32));
        const float mnew = fmaxf(mrun, mx); const float alpha = __builtin_amdgcn_exp2f(mrun - mnew); mrun = mnew;
        float a[16]; float ps = 0.f;
#pragma unroll
        for (int r = 0; r < 16; ++r) { a[r] = __builtin_amdgcn_exp2f(s[r] - mnew); ps += a[r]; }
        lsum = lsum * alpha + ps;
        if (__any(alpha != 1.0f)) {
#pragma unroll
            for (int d = 0; d < 4; ++d)
#pragma unroll
                for (int r = 0; r < 16; ++r) o[d][r] *= alpha;
        }
        u32x4 p0, p1;
        p0.x = cvtpk(a[0], a[1]); p0.y = cvtpk(a[2], a[3]); p0.z = cvtpk(a[4], a[5]); p0.w = cvtpk(a[6], a[7]);
        p1.x = cvtpk(a[8], a[9]); p1.y = cvtpk(a[10], a[11]); p1.z = cvtpk(a[12], a[13]); p1.w = cvtpk(a[14], a[15]);
        const bf16x8 pb0 = __builtin_bit_cast(bf16x8, p0), pb1 = __builtin_bit_cast(bf16x8, p1);
        bf16x8 vf[4][2];
        if (more) asm volatile("s_waitcnt vmcnt(8)" ::: "memory"); else asm volatile("s_waitcnt vmcnt(0)" ::: "memory");
        attn_read_v(T, vf);
        asm volatile("s_waitcnt lgkmcnt(0)" ::: "memory");
        if (more) attn_issue_v(T, sb + 32);
#pragma unroll
        for (int d = 0; d < 4; ++d) { o[d] = MFMA32(vf[d][0], pb0, o[d]); o[d] = MFMA32(vf[d][1], pb1, o[d]); }
    }
    lsum += __shfl_xor(lsum, 32);
    const float inv = 1.0f / lsum;
    attn_store_o(T, o, inv, Y + (rowbase + t0) * 1024 + h * HD, lane);
}

__device__ __forceinline__ void ca_wg_unit(const bf16_t* __restrict__ QK, const bf16_t* __restrict__ VT, bf16_t* __restrict__ Y, const LAS float* bias, LAS unsigned char* lds, int b, int h, int g, int wave, int lane) {
    constexpr int NS = 4;
    const int r32 = lane & 31, hi = lane >> 5, t0 = 256 * g + 32 * wave, q = t0 + r32;
    const int ch = 4 * g + (wave >> 1);
    const int kmin = (g >= 2) ? 64 * (4 * g - 8) : 0;
    const int ntiles = (64 * (4 * g + 4) - kmin) >> 5;
    const int klo = (ch >= 8) ? 64 * (ch - 8) : 0, khi = 64 * (ch + 1);
    const int tlo = (klo - kmin) >> 5, thi = (khi - kmin) >> 5;
    const size_t rowbase = (size_t)b * SEQ;
    const bf16_t* Qp = QK + (rowbase + q) * QKP + 2048 + h * HD + 8 * hi;
    bf16x8 qf[8];
#pragma unroll
    for (int ks = 0; ks < 8; ++ks) qf[ks] = *(const bf16x8*)(Qp + 16 * ks);
    const int l4 = lane >> 4, c0 = lane & 15, gq = wave & 3, pi_w = (wave & 4) | ((gq == 1) ? 2 : ((gq == 2) ? 1 : gq));
    const bf16_t* ksrc = QK + (rowbase + kmin + 4 * pi_w + l4) * QKP + 3072 + h * HD + ((c0 ^ (4 * gq + l4)) * 8);
    const int vr = lane >> 2, vc = (lane & 3) ^ ((vr >> 2) & 3);
    const bf16_t* vsrc = VT + ((size_t)b * (SEQ / 32) + (kmin >> 5)) * 65536 + (size_t)(1024 + h * HD + 16 * wave + vr) * 32 + vc * 8;
    LAS unsigned char* kdst = lds + wave * 1024; LAS unsigned char* vdst = lds + 8192 + wave * 1024;
#define CAW_ISSUE(tile, slot) do { __builtin_amdgcn_global_load_lds((const unsigned*)(ksrc + (size_t)(tile) * 32 * QKP), (LAS unsigned*)(kdst + (slot) * 16384), 16, 0, 0); \
        __builtin_amdgcn_global_load_lds((const unsigned*)(vsrc + (size_t)(tile) * 65536), (LAS unsigned*)(vdst + (slot) * 16384), 16, 0, 0); } while (0)
    const int kro = r32 * 256, r15 = lane & 15, sw = (r32 >> 2) & 3;
    const int vro0 = 8192 + r32 * 64 + ((hi ^ sw) * 16), vro1 = 8192 + r32 * 64 + (((2 + hi) ^ sw) * 16);
    const LAS float* bh = bias + h * NREL;
    f32x16 o[4];
#pragma unroll
    for (int d = 0; d < 4; ++d)
#pragma unroll
        for (int r = 0; r < 16; ++r) o[d][r] = 0.f;
    float mrun = -1e30f, lsum = 0.f;
    CAW_ISSUE(0, 0); CAW_ISSUE(1, 1); CAW_ISSUE(2, 2);
    for (int tau = 0; tau < ntiles; ++tau) {
        asm volatile("s_waitcnt vmcnt(4) lgkmcnt(0)\n\ts_barrier" ::: "memory");
        { const int nx = (tau + 3 < ntiles) ? tau + 3 : ntiles - 1; const int sl = (tau + 3) & 3; CAW_ISSUE(nx, sl); }
        if (tau >= tlo && tau < thi) {
            const int sb = kmin + 32 * tau;
            LAS unsigned char* wl = lds + (tau & 3) * 16384;
            bf16x8 kf[8];
#pragma unroll
            for (int ks = 0; ks < 8; ++ks) kf[ks] = *(const LAS bf16x8*)(wl + kro + (((2 * ks + hi) ^ r15) * 16));
            f32x16 s;
#pragma unroll
            for (int r = 0; r < 16; ++r) s[r] = 0.f;
#pragma unroll
            for (int ks = 0; ks < 8; ++ks) s = MFMA32(kf[ks], qf[ks], s);
            float mx = -1e30f;
            if (sb + 31 - t0 <= -128) {
                const float b0 = bh[0];
#pragma unroll
                for (int r = 0; r < 16; ++r) { s[r] += b0; mx = fmaxf(mx, s[r]); }
            } else {
#pragma unroll
                for (int r = 0; r < 16; ++r) { const int rel = sb + 16 * (r >> 3) + 8 * hi + (r & 7) - q; const int idx = min(max(rel, -128), 63) + 128;
                    s[r] += bh[idx]; mx = fmaxf(mx, s[r]); }
            }
            mx = fmaxf(mx, __shfl_xor(mx, 32));
            const float mnew = fmaxf(mrun, mx); const float alpha = __builtin_amdgcn_exp2f(mrun - mnew); mrun = mnew;
            float a[16]; float ps = 0.f;
#pragma unroll
            for (int r = 0; r < 16; ++r) { a[r] = __builtin_amdgcn_exp2f(s[r] - mnew); ps += a[r]; }
            lsum = lsum * alpha + ps;
            if (__any(alpha != 1.0f)) {
#pragma unroll
                for (int d = 0; d < 4; ++d)
#pragma unroll
                    for (int r = 0; r < 16; ++r) o[d][r] *= alpha;
            }
            u32x4 p0, p1;
            p0.x = cvtpk(a[0], a[1]); p0.y = cvtpk(a[2], a[3]); p0.z = cvtpk(a[4], a[5]); p0.w = cvtpk(a[6], a[7]);
            p1.x = cvtpk(a[8], a[9]); p1.y = cvtpk(a[10], a[11]); p1.z = cvtpk(a[12], a[13]); p1.w = cvtpk(a[14], a[15]);
            const bf16x8 pb0 = __builtin_bit_cast(bf16x8, p0), pb1 = __builtin_bit_cast(bf16x8, p1);
            bf16x8 vf[4][2];
#pragma unroll
            for (int d = 0; d < 4; ++d) { vf[d][0] = *(const LAS bf16x8*)(wl + vro0 + d * 2048); vf[d][1] = *(const LAS bf16x8*)(wl + vro1 + d * 2048); }
#pragma unroll
            for (int d = 0; d < 4; ++d) { o[d] = MFMA32(vf[d][0], pb0, o[d]); o[d] = MFMA32(vf[d][1], pb1, o[d]); }
        }
    }
#undef CAW_ISSUE
    asm volatile("s_waitcnt vmcnt(0) lgkmcnt(0)\n\ts_barrier" ::: "memory");
    lsum += __shfl_xor(lsum, 32);
    const float inv = 1.0f / lsum;
    AttnTile T; T.wl = lds + 65536 + wave * 8192;
    attn_store_o(T, o, inv, Y + (rowbase + t0) * 1024 + h * HD, lane);
    asm volatile("s_waitcnt vmcnt(0)" ::: "memory");
}

__device__ __forceinline__ int fresh_tid() { int t = threadIdx.x; asm volatile("" : "+v"(t)); return t; }
#define XB_TMO      128
#define XB_XCNT(j)  (256  + 64 * (j))
#define XB_XSUB(j)  (1280 + 64 * (j))
#define XB_XGEN(j)  (2304 + 64 * (j))
#define XB_TOP      3328
#define XB_TOPGEN   3392
#define XCD_BAR_WORDS 3456
#define XB_SPIN_CAP (1u << 18)
__device__ __forceinline__ unsigned xb_ld(unsigned* p)              { return __hip_atomic_load(p, __ATOMIC_RELAXED, __HIP_MEMORY_SCOPE_AGENT); }
__device__ __forceinline__ unsigned xb_add(unsigned* p, unsigned v) { return __hip_atomic_fetch_add(p, v, __ATOMIC_RELAXED, __HIP_MEMORY_SCOPE_AGENT); }
__device__ __forceinline__ unsigned xb_xcc_id() { return (unsigned)__builtin_amdgcn_s_getreg((3 << 11) | 20) & 0xFu; }
#define XB_SPIN(cond, bar) do { unsigned _sp = 0; while (cond) { __builtin_amdgcn_s_sleep(1); \
    if ((++_sp & 255u) == 0u) { if (xb_ld(&(bar)[XB_TMO])) break; if (_sp > XB_SPIN_CAP) { atomicAdd(&(bar)[XB_TMO], 1u); break; } } } } while (0)
struct XcdBarrier { unsigned* bar; unsigned x; volatile LAS unsigned* st; };
__device__ __forceinline__ XcdBarrier xcd_barrier_post(unsigned* bar, volatile LAS unsigned* st) {
    XcdBarrier b; b.bar = bar; b.x = xb_xcc_id(); b.st = st;
    if (fresh_tid() == 0) (void)xb_add(&bar[XB_XCNT(b.x)], 1u);
    return b;
}
__device__ __forceinline__ void xcd_barrier_complete(unsigned* bar, unsigned x, unsigned& nloc, unsigned& nx) {
    const unsigned G = gridDim.x * gridDim.y * gridDim.z;
    unsigned sum, cnt, mine, sp = 0u;
    for (;;) {
        sum = 0u; cnt = 0u; mine = 0u;
#pragma unroll
        for (unsigned j = 0; j < 16; ++j) { const unsigned c = xb_ld(&bar[XB_XCNT(j)]); sum += c; cnt += (c > 0u) ? 1u : 0u; mine = (j == x) ? c : mine; }
        if (sum == G) break;
        __builtin_amdgcn_s_sleep(1);
        if ((++sp & 255u) == 0u) { if (xb_ld(&bar[XB_TMO])) break; if (sp > XB_SPIN_CAP) { atomicAdd(&bar[XB_TMO], 1u); break; } }
    }
    nloc = mine > 0u ? mine : 1u; nx = cnt > 0u ? cnt : 1u;
}
__device__ __forceinline__ void xcd_barrier(const XcdBarrier& b, int wave  ) {
    asm volatile("s_waitcnt vmcnt(0)" ::: "memory");
    __syncthreads();
    if (wave == 0 && __builtin_amdgcn_mbcnt_hi(~0u, __builtin_amdgcn_mbcnt_lo(~0u, 0u)) == 0u) {
        unsigned* bar = b.bar;
        __builtin_amdgcn_s_waitcnt(0);
        unsigned nloc = b.st[0], nx = b.st[1];
        if (nloc == 0u) { xcd_barrier_complete(bar, b.x, nloc, nx); b.st[0] = nloc; b.st[1] = nx; }
        const unsigned old = xb_add(&bar[XB_XSUB(b.x)], 1u);
        const unsigned gen = old / nloc;
        if (old + 1u == (gen + 1u) * nloc) {
            __builtin_amdgcn_fence(__ATOMIC_RELEASE, "agent");
            asm volatile("s_waitcnt vmcnt(0)" ::: "memory");
            const unsigned og = xb_add(&bar[XB_TOP], 1u);
            const unsigned tg = og / nx;
            if (og + 1u == (tg + 1u) * nx) xb_add(&bar[XB_TOPGEN], 1u);
            else XB_SPIN(xb_ld(&bar[XB_TOPGEN]) == tg, bar);
            __builtin_amdgcn_fence(__ATOMIC_ACQUIRE, "agent");
            xb_add(&bar[XB_XGEN(b.x)], 1u);
            asm volatile("s_waitcnt vmcnt(0)" ::: "memory");
        } else {
            XB_SPIN(xb_ld(&bar[XB_XGEN(b.x)]) == gen, bar);
            __builtin_amdgcn_fence(__ATOMIC_ACQUIRE, "agent");
            asm volatile("s_waitcnt vmcnt(0)" ::: "memory");
        }
    }
    __syncthreads();
}

constexpr int NWAVES = 8;
constexpr int LDS_BYTES = 147456;
struct Args { const float* in[15]; float* out; unsigned char* ws; };

__global__ void __launch_bounds__(NWAVES * 64, 2) mega_fwd(Args args) {
    extern __shared__ __attribute__((aligned(16))) unsigned char lds_raw[];
    LAS unsigned char* lds = (LAS unsigned char*)lds_raw;
    cg::grid_group grid = cg::this_grid();
    const int tid = fresh_tid(), lane = tid & 63, wave = __builtin_amdgcn_readfirstlane(tid >> 6);
    const int G = gridDim.x, bx = blockIdx.x;
    const int gw = bx * NWAVES + wave, NGW = G * NWAVES;

    const float* x = args.in[0]; const float* p = args.in[1]; const float* w_in = args.in[2]; const float* w_sb_out = args.in[3]; const float* w_ca_out = args.in[4];
    const float* w_mix_out = args.in[5]; const float* rel_bias = args.in[6]; const float* g_mix = args.in[7]; const float* g_ffn = args.in[8]; const float* g_ple = args.in[9];
    const float* g_final = args.in[10]; const float* w_ffn_in = args.in[11]; const float* w_ffn_out = args.in[12]; const float* w_ple_in = args.in[13]; const float* w_ple_gate = args.in[14];
    unsigned char* ws = args.ws; float* out = args.out;
    bf16_t* WINA = (bf16_t*)(ws + WS_WINA); bf16_t* WINV = (bf16_t*)(ws + WS_WINV); bf16_t* WSB = (bf16_t*)(ws + WS_WSB); bf16_t* WCA = (bf16_t*)(ws + WS_WCA);
    bf16_t* WMIX = (bf16_t*)(ws + WS_WMIX); bf16_t* WFI = (bf16_t*)(ws + WS_WFI); bf16_t* WFO = (bf16_t*)(ws + WS_WFO); bf16_t* WPI = (bf16_t*)(ws + WS_WPI); bf16_t* WPG = (bf16_t*)(ws + WS_WPG);
    bf16_t* PBF = (bf16_t*)(ws + WS_PBF); float* SS = (float*)(ws + WS_SS);
    bf16_t* R1 = (bf16_t*)(ws + WS_R1); bf16_t* GB = (bf16_t*)(ws + WS_G); bf16_t* XN = (bf16_t*)(ws + WS_XN); bf16_t* HB = (bf16_t*)(ws + WS_H);
    bf16_t* QK = (bf16_t*)(ws + WS_QK); bf16_t* TMP = (bf16_t*)(ws + WS_QK); bf16_t* TMP2 = (bf16_t*)(ws + WS_R1);
    bf16_t* VT = (bf16_t*)out; bf16_t* YSB = (bf16_t*)((unsigned char*)out + 64 * MiB); bf16_t* YCA = (bf16_t*)((unsigned char*)out + 96 * MiB);
    float* ss1 = SS; float* ss2 = SS + MTOK; float* ss3 = SS + 2 * MTOK;
    bf16_t* XB = (bf16_t*)(ws + WS_QK + 64 * MiB);
    volatile LAS unsigned* bst = (volatile LAS unsigned*)(lds + LDS_BYTES - 64);
    if (tid < 2) bst[tid] = 0u;
    __syncthreads();
    (void)xcd_barrier_post((unsigned*)(ws + WS_CTL), bst);
#define SEAM() do { XcdBarrier b_; b_.bar = (unsigned*)(ws + WS_CTL); b_.x = xb_xcc_id(); b_.st = bst; xcd_barrier(b_, wave); } while (0)

    for (int rep_ = 0; rep_ < 1 + XP_DUP_P0; ++rep_) {
        LAS float* scr = (LAS float*)(lds + wave * 16640);
        constexpr int I1 = (DM / 64) * (2048 / 64), I2 = (DM / 64) * (1024 / 64), I5 = (DM / 64) * (4096 / 64);
        constexpr int I6 = (1024 / 64) * (DM / 64), I8 = (DM / 64) * (DM / 64), I9 = (DM / 64) * (2 * DFF / 64), I10 = (DFF / 64) * (DM / 64), I11 = (DPLE / 64) * (DM / 64);
        constexpr int NITEMS = I1 + I2 + I1 + I2 + I5 + I6 + I6 + I8 + I9 + I10 + I11 + I8;
        for (int it = gw; it < NITEMS; it += NGW) {
            int r = it;
            if (r < I1) { tr_item(w_in, DM, INCOLS, 0, 2048, WINA, 0, false, g_mix, scr, r, lane); continue; } r -= I1;
            if (r < I2) { tr_item(w_in, DM, INCOLS, 2048, 1024, WINV, 0, false, g_mix, scr, r, lane); continue; } r -= I2;
            if (r < I1) { tr_item(w_in, DM, INCOLS, 3072, 2048, WINA, 2048, false, g_mix, scr, r, lane); continue; } r -= I1;
            if (r < I2) { tr_item(w_in, DM, INCOLS, 5120, 1024, WINV, 1024, false, g_mix, scr, r, lane); continue; } r -= I2;
            if (r < I5) { tr_item(w_in, DM, INCOLS, 6144, 4096, WINA, 4096, false, g_mix, scr, r, lane); continue; } r -= I5;
            if (r < I6) { tr_item(w_sb_out, 1024, DM, 0, DM, WSB, 0, false, nullptr, scr, r, lane); continue; } r -= I6;
            if (r < I6) { tr_item(w_ca_out, 1024, DM, 0, DM, WCA, 0, false, nullptr, scr, r, lane); continue; } r -= I6;
            if (r < I8) { tr_item(w_mix_out, DM, DM, 0, DM, WMIX, 0, false, nullptr, scr, r, lane); continue; } r -= I8;
            if (r < I9) { tr_item(w_ffn_in, DM, 2 * DFF, 0, 2 * DFF, WFI, 0, true, g_ffn, scr, r, lane); continue; } r -= I9;
            if (r < I10) { tr_item(w_ffn_out, DFF, DM, 0, DM, WFO, 0, false, nullptr, scr, r, lane); continue; } r -= I10;
            if (r < I11) { tr_item(w_ple_in, DPLE, DM, 0, DM, WPI, 0, false, nullptr, scr, r, lane); continue; } r -= I11;
            tr_item(w_ple_gate, DM, DM, 0, DM, WPG, 0, false, g_ple, scr, r, lane);
        }
        for (int m = gw; m < MTOK; m += 2 * NGW) {
            const int m1 = (m + NGW < MTOK) ? m + NGW : m;
            const f32x4* xa = (const f32x4*)(x + (size_t)m * DM) + lane; const f32x4* xb = (const f32x4*)(x + (size_t)m1 * DM) + lane;
            f32x4 va[8], vb[8]; float sa = 0.f, sb_ = 0.f;
#pragma unroll
            for (int j = 0; j < 8; ++j) { va[j] = xa[64 * j]; vb[j] = xb[64 * j]; }
#pragma unroll
            for (int j = 0; j < 8; ++j) { sa += (va[j].x * va[j].x + va[j].y * va[j].y) + (va[j].z * va[j].z + va[j].w * va[j].w); sb_ += (vb[j].x * vb[j].x + vb[j].y * vb[j].y) + (vb[j].z * vb[j].z + vb[j].w * vb[j].w); }
            const float ra = 1.0f / sqrtf(wave_sum(sa) * (1.0f / DM) + EPS), rb = 1.0f / sqrtf(wave_sum(sb_) * (1.0f / DM) + EPS);
            u32x2* oa = (u32x2*)(R1 + (size_t)m * DM) + lane; u32x2* ob = (u32x2*)(R1 + (size_t)m1 * DM) + lane;
#pragma unroll
            for (int j = 0; j < 8; ++j) { const f32x4 ya = va[j] * ra, yb = vb[j] * rb; u32x2 wa, wb; wa.x = pg8::cvt_pk_bf16(ya.x, ya.y); wa.y = pg8::cvt_pk_bf16(ya.z, ya.w); wb.x = pg8::cvt_pk_bf16(yb.x, yb.y); wb.y = pg8::cvt_pk_bf16(yb.z, yb.w);
                oa[64 * j] = wa; ob[64 * j] = wb; }
        }
        {
            const size_t n4 = (size_t)MTOK * DPLE / 4; const size_t gt = (size_t)bx * 512 + tid, GT = (size_t)G * 512;
            for (size_t i = gt; i < n4; i += 4 * GT) {
                f32x4 v[4];
#pragma unroll
                for (int k = 0; k < 4; ++k) { const size_t ik = i + (size_t)k * GT; v[k] = ((const f32x4*)p)[ik < n4 ? ik : i]; }
#pragma unroll
                for (int k = 0; k < 4; ++k) { const size_t ik = i + (size_t)k * GT; if (ik < n4) { u32x2 w; w.x = pk2(v[k].x, v[k].y); w.y = pk2(v[k].z, v[k].w); ((u32x2*)PBF)[ik] = w; } }
            }
            for (size_t i = gt; i < (size_t)3 * MTOK; i += GT) SS[i] = 0.f;
        }
    }
    if (args.ws == nullptr) grid.sync();
    SEAM();

    for (int rep_ = 0; rep_ < 1 + XP_DUP_P1; ++rep_) {
        pg8::Gemm g{R1, WINA, MTOK, 8192, DM}; pg8::StaticOrder S; S.init(MTOK, 8192, G, bx);
        pg8::EpiInProj E{QK, GB};
        pg8::gemm_phase<pg8::EpiInProj, pg8::StaticOrder, true, true, XP_KREP>(lds, g, S, E);
    }
    {
        pg8::Gemm g{WINV, R1, 2048, MTOK, DM}; pg8::StaticOrder S; S.init(2048, MTOK, G, bx);
        pg8::EpiBf16Plain E{VT, MTOK};
        pg8::gemm_phase<pg8::EpiBf16Plain, pg8::StaticOrder, true, true>(lds, g, S, E);
    }
    SEAM();

    for (int xs_ = 0; xs_ < XP_EXTRA_SYNCS; ++xs_) grid.sync();
    for (int rep_ = 0; rep_ < 1 + XP_DUP_P2; ++rep_) {
        int tid2 = threadIdx.x; asm volatile("" : "+v"(tid2)); const int lane = tid2 & 63;
        LAS float* bl = (LAS float*)(lds + 131072 + 1024);
        for (int i = tid2; i < NH * NREL; i += NWAVES * 64) bl[i] = rel_bias[i] * LOG2E;
        __syncthreads();
        const int vcu = (G % 8 == 0) ? (bx % 8) * (G / 8) + bx / 8 : bx;
        for (int i = 0, u = vcu; u < NB * NH * 8; ++i, u += G) { const int bh_ = u >> 3; int g = u & 7; if (i & 1) g = 7 - g;
            ca_wg_unit(QK, VT, YCA, bl, lds, bh_ >> 3, bh_ & 7, g, wave, lane); }
        __syncthreads();
        LAS unsigned char* wl = lds + wave * 16384;
        constexpr int NU = NB * NH * (SEQ / 32);
        for (int u = vcu * NWAVES + wave; u < NU; u += NGW) { const int qb = u & 63, h = (u >> 6) & 7, b = u >> 9; sb_unit(QK, VT, YSB, wl, b, h, qb, lane); }
    }
    SEAM();

    {
        pg8::Gemm g{YSB, WSB, MTOK, DM, 1024}; pg8::StaticOrder S; S.init(MTOK, DM, G, bx);
        pg8::EpiGate<0> E{GB, 0, TMP, R1};
        pg8::gemm_phase<pg8::EpiGate<0>, pg8::StaticOrder, true, true>(lds, g, S, E);
    }
    {
        pg8::Gemm g{YCA, WCA, MTOK, DM, 1024}; pg8::StaticOrder S; S.init(MTOK, DM, G, bx);
        pg8::EpiGate<1> E{GB, 2048, TMP, R1};
        pg8::gemm_phase<pg8::EpiGate<1>, pg8::StaticOrder, true, true>(lds, g, S, E);
    }
    SEAM();

    {
        pg8::Gemm g{R1, WMIX, MTOK, DM, DM}; pg8::StaticOrder S; S.init(MTOK, DM, G, bx);
        pg8::EpiResid<false> E{x, XN, ss1};
        pg8::gemm_phase<pg8::EpiResid<false>, pg8::StaticOrder, true, true>(lds, g, S, E);
    }
    SEAM();

    {
        pg8::Gemm g{XN, WFI, MTOK, 2 * DFF, DM}; pg8::StaticOrder S; S.init(MTOK, 2 * DFF, G, bx);
        pg8::EpiSwiGLU E{HB, ss1};
        pg8::gemm_phase<pg8::EpiSwiGLU, pg8::StaticOrder, true, true>(lds, g, S, E);
    }
    SEAM();

    {
        pg8::Gemm g{HB, WFO, MTOK, DM, DFF}; pg8::StaticOrder S; S.init(MTOK, DM, G, bx);
        pg8::EpiResid<true> E{nullptr, XN, ss2};
        pg8::gemm_phase<pg8::EpiResid<true>, pg8::StaticOrder, true, true>(lds, g, S, E);
    }
    {
        pg8::Gemm g{PBF, WPI, MTOK, DM, DPLE}; pg8::StaticOrder S; S.init(MTOK, DM, G, bx);
        pg8::EpiStoreBf16T E{TMP2};
        pg8::gemm_phase<pg8::EpiStoreBf16T, pg8::StaticOrder, true, true>(lds, g, S, E);
    }
    SEAM();

    {
        pg8::Gemm g{XN, WPG, MTOK, DM, DM}; pg8::StaticOrder S; S.init(MTOK, DM, G, bx);
        pg8::EpiPle E{XN, XB, TMP2, ss2, ss3};
        pg8::gemm_phase<pg8::EpiPle, pg8::StaticOrder, true, true>(lds, g, S, E);
    }
    SEAM();

    int tid8 = threadIdx.x; asm volatile("" : "+v"(tid8)); const int lane8 = tid8 & 63;
    for (int m = gw; m < MTOK; m += 2 * NGW) {
        const int m1 = m + NGW; const bool two = m1 < MTOK;
        const u32x4* xr0 = (const u32x4*)(XB + (size_t)m * DM) + lane8; const u32x4* xr1 = (const u32x4*)(XB + (size_t)(two ? m1 : m) * DM) + lane8;
        const f32x4* gr = (const f32x4*)g_final;
        u32x4 w0[4], w1[4];
#pragma unroll
        for (int j = 0; j < 4; ++j) { w0[j] = xr0[64 * j]; w1[j] = xr1[64 * j]; }
        const float rs0 = 1.0f / sqrtf(ss3[m] * (1.0f / DM) + EPS), rs1 = 1.0f / sqrtf(ss3[two ? m1 : m] * (1.0f / DM) + EPS);
        f32x4* o0 = (f32x4*)(out + (size_t)m * DM); f32x4* o1 = (f32x4*)(out + (size_t)m1 * DM);
#pragma unroll
        for (int j = 0; j < 4; ++j) { const int e = (lane8 + 64 * j) * 2; f32x4 a, b; const f32x4 g0 = gr[e], g1 = gr[e + 1];
            pg8::bf8_to_f32(w0[j], a, b); o0[e] = a * rs0 * g0; o0[e + 1] = b * rs0 * g1;
            if (two) { pg8::bf8_to_f32(w1[j], a, b); o1[e] = a * rs1 * g0; o1[e + 1] = b * rs1 * g1; } }
    }
}

extern "C" void kernel_launch(void* const* d_in, const int* in_sizes, int n_in, void* d_out, int out_size, void* d_ws, size_t ws_size, hipStream_t stream) {
    static int grid = 0;
    if (grid == 0) {
        if (n_in != 15 || out_size != MTOK * DM || ws_size < WS_END) { fprintf(stderr, "kernel_launch: unexpected problem (n_in %d, out %d, ws %zu)\n", n_in, out_size, ws_size); grid = -1; return; }
        int dev = 0, cus = 0, per_cu = 0;
        hipGetDevice(&dev);
        hipDeviceGetAttribute(&cus, hipDeviceAttributeMultiprocessorCount, dev);
        if (hipFuncSetAttribute((const void*)mega_fwd, hipFuncAttributeMaxDynamicSharedMemorySize, LDS_BYTES) != hipSuccess) { fprintf(stderr, "kernel_launch: hipFuncSetAttribute failed\n"); grid = -1; return; }
        if (hipOccupancyMaxActiveBlocksPerMultiprocessor(&per_cu, (const void*)mega_fwd, NWAVES * 64, LDS_BYTES) != hipSuccess || per_cu < 1) { per_cu = 1; (void)hipGetLastError(); }
        grid = cus * per_cu;
    }
    if (grid < 0) return;
    Args a{};
    for (int i = 0; i < 15; ++i) a.in[i] = (const float*)d_in[i];
    a.out = (float*)d_out; a.ws = (unsigned char*)d_ws;
    if (hipMemsetAsync((char*)d_ws + WS_CTL, 0, CTL_BYTES, stream) != hipSuccess) { fprintf(stderr, "kernel_launch: memset failed\n"); return; }
    void* kargs[] = {&a};
    hipError_t e = hipLaunchCooperativeKernel((const void*)mega_fwd, dim3(grid), dim3(NWAVES * 64), kargs, LDS_BYTES, stream);
    if (e != hipSuccess) fprintf(stderr, "cooperative launch failed: %s (grid %d)\n", hipGetErrorString(e), grid);
}
```

```cpp
#include <hip/hip_runtime.h>
#include <hip/hip_cooperative_groups.h>
#include <cstdio>
#include <cstdint>
namespace cg = cooperative_groups;
#ifndef XP_DUP_P0
#define XP_DUP_P0 0
#endif
#ifndef XP_DUP_P2
#define XP_DUP_P2 0
#endif
#ifndef XP_DUP_P1
#define XP_DUP_P1 0
#endif
#ifndef XP_KREP
#define XP_KREP 1
#endif
#ifndef XP_EXTRA_SYNCS
#define XP_EXTRA_SYNCS 0
#endif

#define LAS __attribute__((address_space(3)))
typedef unsigned short bf16_t;
typedef short bf16x8 __attribute__((ext_vector_type(8)));
typedef float f32x4 __attribute__((ext_vector_type(4)));
typedef float f32x16 __attribute__((ext_vector_type(16)));
typedef unsigned u32x4 __attribute__((ext_vector_type(4)));
typedef unsigned u32x2 __attribute__((ext_vector_type(2)));

constexpr int DM = 2048, NB = 8, SEQ = 2048, MTOK = NB * SEQ;
constexpr int NH = 8, HD = 128, DFF = 5632, DPLE = 256, INCOLS = 10240;
constexpr int QKP = 4096;
constexpr int NREL = 192;
constexpr float EPS = 1e-6f;
constexpr float LOG2E = 1.4426950408889634f;
constexpr float QSCALE = 0.08838834764831845f * LOG2E;

constexpr size_t MiB = 1u << 20;
constexpr size_t WS_WINA = 0 * MiB;
constexpr size_t WS_WINV = 32 * MiB;
constexpr size_t WS_WSB = 40 * MiB;
constexpr size_t WS_WCA = 44 * MiB;
constexpr size_t WS_WMIX = 48 * MiB;
constexpr size_t WS_WFI = 56 * MiB;
constexpr size_t WS_WFO = 100 * MiB;
constexpr size_t WS_WPI = 122 * MiB;
constexpr size_t WS_WPG = 123 * MiB;
constexpr size_t WS_PBF = 131 * MiB;
constexpr size_t WS_SS = 139 * MiB;
constexpr size_t WS_CTL = 139 * MiB + 512 * 1024, CTL_BYTES = 16384;
constexpr size_t WS_R1 = 140 * MiB;
constexpr size_t WS_G = 204 * MiB;
constexpr size_t WS_XN = 204 * MiB;
constexpr size_t WS_H = 268 * MiB;
constexpr size_t WS_QK = 332 * MiB;
constexpr size_t WS_END = 460 * MiB;

namespace pg8 {
constexpr int BM = 256, BK = 64, HALF = 128, HTB = HALF * BK * 2, STAGE_BYTES = 8 * HTB, NXCD = 8, WGM = 4;
__host__ __device__ __forceinline__ int lds_byte(int r, int c) { const int st = (r >> 4) * 2 + (c >> 5), rr = r & 15, cc = c & 31, ob = rr * 64 + cc * 2; return st * 1024 + (ob ^ (((ob >> 9) & 1) << 5)); }
__host__ __device__ __forceinline__ void stage_rc(int b, int& R, int& C) { const int st = b / 1024, sb = b % 1024, swz = sb ^ (((sb >> 9) & 1) << 5); R = (st >> 1) * 16 + swz / 64; C = (st & 1) * 32 + (swz % 64) / 2; }
__host__ __device__ __forceinline__ int perm32(int rho) { const int n = rho >> 4, i = rho & 15; return 8 * (i >> 2) + 4 * n + (i & 3); }

struct Unit { int pm, pn; };
struct Gemm { const bf16_t* A; const bf16_t* Bt; int M, N, K; };

struct StaticOrder {
    int nM, nN, nwg, G, c;
    __host__ __device__ void init(int M, int N, int G_, int c_) { nM = M / BM; nN = N / BM; nwg = nM * nN; G = G_; c = c_; }
    __host__ __device__ bool next(int i, Unit& u) const {
        const long L = (long)i * G + c; if (L >= nwg) return false;
        int wgid = (int)L; { const int q = nwg / NXCD, r = nwg % NXCD, xcd = wgid % NXCD, off = wgid / NXCD; wgid = (xcd < r ? xcd * (q + 1) : r * (q + 1) + (xcd - r) * q) + off; }
        const int nig = WGM * nN, gid = wgid / nig, fm = gid * WGM, gsz = (nM - fm) < WGM ? (nM - fm) : WGM;
        u.pm = fm + ((wgid % nig) % gsz); u.pn = (wgid % nig) / gsz; return true;
    }
    __device__ __forceinline__ void a_ready(const Unit&) const {}
    __device__ __forceinline__ void done(const Unit&) const {}
};

__device__ __forceinline__ unsigned cvt_pk_bf16(float lo, float hi) { unsigned r; asm volatile("v_cvt_pk_bf16_f32 %0, %1, %2" : "=v"(r) : "v"(lo), "v"(hi)); return r; }
__device__ __forceinline__ float sigmoidf_(float x) { return __builtin_amdgcn_rcpf(1.0f + __builtin_amdgcn_exp2f(-x * LOG2E)); }
__device__ __forceinline__ float bf2f(unsigned short b) { return __uint_as_float((unsigned)b << 16); }


struct EpiInProj {
    static constexpr bool PERM = true, AFTER_DRAIN = false;
    bf16_t* QK; bf16_t* G;
    __device__ __forceinline__ void operator()(const f32x4 (&acc)[2][2][4][2], const Unit& u, int wr, int wc, int fr, int fq) const {
        const int row0 = u.pm * BM + wr * 64 + fr;
        const bool isg = u.pn >= 16;
        const int pn = isg ? u.pn - 16 : u.pn;
        bf16_t* base = isg ? G : QK;
        const float sc = (((u.pn & 4) == 0) ? QSCALE : 1.0f) * (1.0f / XP_KREP);
        const int col0 = pn * BM + wc * 32 + 8 * fq;
#pragma unroll
        for (int ai = 0; ai < 2; ++ai)
#pragma unroll
            for (int m = 0; m < 4; ++m) { bf16_t* rowp = base + (size_t)(row0 + ai * HALF + m * 16) * QKP + col0;
#pragma unroll
                for (int bj = 0; bj < 2; ++bj) { f32x4 v0 = acc[ai][bj][m][0], v1 = acc[ai][bj][m][1];
                    if (isg) {
#pragma unroll
                        for (int i = 0; i < 4; ++i) { v0[i] = sigmoidf_(v0[i] * (1.0f / XP_KREP)); v1[i] = sigmoidf_(v1[i] * (1.0f / XP_KREP)); }
                    } else { v0 = v0 * sc; v1 = v1 * sc; }
                    u32x4 w; w.x = cvt_pk_bf16(v0[0], v0[1]); w.y = cvt_pk_bf16(v0[2], v0[3]); w.z = cvt_pk_bf16(v1[0], v1[1]); w.w = cvt_pk_bf16(v1[2], v1[3]);
                    *(u32x4*)(rowp + bj * HALF) = w; } }
    }
};
struct EpiBf16Plain {
    static constexpr bool PERM = true, AFTER_DRAIN = false;
    bf16_t* O; int ldc;
    __device__ __forceinline__ void operator()(const f32x4 (&acc)[2][2][4][2], const Unit& u, int wr, int wc, int fr, int fq) const {
        const int row0 = u.pm * BM + wr * 64 + fr;
        const int tb0 = u.pn * 8 + wc;
#pragma unroll
        for (int ai = 0; ai < 2; ++ai)
#pragma unroll
            for (int m = 0; m < 4; ++m) { const int row = row0 + ai * HALF + m * 16;
#pragma unroll
                for (int bj = 0; bj < 2; ++bj) { const f32x4 v0 = acc[ai][bj][m][0], v1 = acc[ai][bj][m][1];
                    u32x4 w; w.x = cvt_pk_bf16(v0[0], v0[1]); w.y = cvt_pk_bf16(v0[2], v0[3]); w.z = cvt_pk_bf16(v1[0], v1[1]); w.w = cvt_pk_bf16(v1[2], v1[3]);
                    *(u32x4*)(O + ((size_t)(tb0 + 4 * bj) * 2048 + row) * 32 + 8 * fq) = w; } }
    }
};
__device__ __forceinline__ void bf8_to_f32(const u32x4 w, f32x4& a, f32x4& b) {
    a[0] = __uint_as_float(w.x << 16); a[1] = __uint_as_float(w.x & 0xffff0000u); a[2] = __uint_as_float(w.y << 16); a[3] = __uint_as_float(w.y & 0xffff0000u);
    b[0] = __uint_as_float(w.z << 16); b[1] = __uint_as_float(w.z & 0xffff0000u); b[2] = __uint_as_float(w.w << 16); b[3] = __uint_as_float(w.w & 0xffff0000u);
}
__device__ __forceinline__ u32x4 f32_to_bf8(const f32x4 a, const f32x4 b) { u32x4 w; w.x = cvt_pk_bf16(a[0], a[1]); w.y = cvt_pk_bf16(a[2], a[3]); w.z = cvt_pk_bf16(b[0], b[1]); w.w = cvt_pk_bf16(b[2], b[3]); return w; }
template <int MODE> struct EpiGate {
    static constexpr bool PERM = true, AFTER_DRAIN = false;
    const bf16_t* G; int goff; bf16_t* TMP; bf16_t* MG;
    __device__ __forceinline__ void operator()(const f32x4 (&acc)[2][2][4][2], const Unit& u, int wr, int wc, int fr, int fq) const {
        const int col0 = u.pn * BM + wc * 32 + 8 * fq;
        u32x4 gw[2][2][2], tw[2][2][2];
#define EG_LOAD(bt, buf) do { _Pragma("unroll") for (int gi = 0; gi < 2; ++gi) { const int ai = ((bt) * 2 + gi) >> 2, m = ((bt) * 2 + gi) & 3; const size_t row = (size_t)(u.pm * BM + ai * HALF + wr * 64 + m * 16 + fr); \
            _Pragma("unroll") for (int bj = 0; bj < 2; ++bj) { const int c = col0 + bj * HALF; gw[buf][gi][bj] = *(const u32x4*)(G + row * QKP + goff + c); if (MODE == 1) tw[buf][gi][bj] = *(const u32x4*)(TMP + row * DM + c); } } } while (0)
        EG_LOAD(0, 0);
#pragma unroll
        for (int bt = 0; bt < 4; ++bt) {
            if (bt + 1 < 4) EG_LOAD(bt + 1, (bt + 1) & 1);
#pragma unroll
            for (int gi = 0; gi < 2; ++gi) { const int ai = (bt * 2 + gi) >> 2, m = (bt * 2 + gi) & 3; const size_t row = (size_t)(u.pm * BM + ai * HALF + wr * 64 + m * 16 + fr);
#pragma unroll
                for (int bj = 0; bj < 2; ++bj) { const int c = col0 + bj * HALF;
                    f32x4 g0, g1; bf8_to_f32(gw[bt & 1][gi][bj], g0, g1);
                    f32x4 v0 = acc[ai][bj][m][0] * g0, v1 = acc[ai][bj][m][1] * g1;
                    if (MODE == 1) { f32x4 t0, t1; bf8_to_f32(tw[bt & 1][gi][bj], t0, t1); v0 = v0 + t0; v1 = v1 + t1; }
                    *(u32x4*)((MODE == 0 ? TMP : MG) + row * DM + c) = f32_to_bf8(v0, v1); } }
            asm volatile("" ::: "memory"); }
#undef EG_LOAD
    }
};
template <bool BASE_BF16> struct EpiResid {
    static constexpr bool PERM = true, AFTER_DRAIN = false;
    const float* basef; bf16_t* X; float* ss;
    __device__ __forceinline__ void operator()(const f32x4 (&acc)[2][2][4][2], const Unit& u, int wr, int wc, int fr, int fq) const {
        const int col0 = u.pn * BM + wc * 32 + 8 * fq;
        f32x4 bsf[2][BASE_BF16 ? 1 : 2][2][2]; u32x4 bsh[2][BASE_BF16 ? 2 : 1][2];
#define ER_LOAD(bt, buf) do { _Pragma("unroll") for (int gi = 0; gi < 2; ++gi) { const int ai = ((bt) * 2 + gi) >> 2, m = ((bt) * 2 + gi) & 3; const size_t row = (size_t)(u.pm * BM + ai * HALF + wr * 64 + m * 16 + fr); \
            _Pragma("unroll") for (int bj = 0; bj < 2; ++bj) { const int c = col0 + bj * HALF; \
                if (BASE_BF16) bsh[buf][BASE_BF16 ? gi : 0][bj] = *(const u32x4*)(X + row * DM + c); \
                else { bsf[buf][BASE_BF16 ? 0 : gi][bj][0] = *(const f32x4*)(basef + row * DM + c); bsf[buf][BASE_BF16 ? 0 : gi][bj][1] = *(const f32x4*)(basef + row * DM + c + 4); } } } } while (0)
        ER_LOAD(0, 0);
#pragma unroll
        for (int bt = 0; bt < 4; ++bt) {
            if (bt + 1 < 4) ER_LOAD(bt + 1, (bt + 1) & 1);
#pragma unroll
            for (int gi = 0; gi < 2; ++gi) { const int ai = (bt * 2 + gi) >> 2, m = (bt * 2 + gi) & 3; const size_t row = (size_t)(u.pm * BM + ai * HALF + wr * 64 + m * 16 + fr); float q = 0.f;
#pragma unroll
                for (int bj = 0; bj < 2; ++bj) { const int c = col0 + bj * HALF;
                    f32x4 b0, b1;
                    if (BASE_BF16) bf8_to_f32(bsh[bt & 1][BASE_BF16 ? gi : 0][bj], b0, b1); else { b0 = bsf[bt & 1][BASE_BF16 ? 0 : gi][bj][0]; b1 = bsf[bt & 1][BASE_BF16 ? 0 : gi][bj][1]; }
                    const f32x4 x0 = b0 + acc[ai][bj][m][0], x1 = b1 + acc[ai][bj][m][1];
                    *(u32x4*)(X + row * DM + c) = f32_to_bf8(x0, x1);
                    q += ((x0[0] * x0[0] + x0[1] * x0[1]) + (x0[2] * x0[2] + x0[3] * x0[3])) + ((x1[0] * x1[0] + x1[1] * x1[1]) + (x1[2] * x1[2] + x1[3] * x1[3])); }
                q += __shfl_xor(q, 16); q += __shfl_xor(q, 32);
                if (fq == 0) __hip_atomic_fetch_add(ss + row, q, __ATOMIC_RELAXED, __HIP_MEMORY_SCOPE_AGENT); }
            asm volatile("" ::: "memory"); }
#undef ER_LOAD
    }
};
struct EpiSwiGLU {
    static constexpr bool PERM = true, AFTER_DRAIN = false;
    bf16_t* H; const float* ss;
    __device__ __forceinline__ void operator()(const f32x4 (&acc)[2][2][4][2], const Unit& u, int wr, int wc, int fr, int fq) const {
        const int col0 = u.pn * HALF + wc * 32 + 8 * fq;
#pragma unroll
        for (int ai = 0; ai < 2; ++ai)
#pragma unroll
            for (int m = 0; m < 4; ++m) { const size_t row = (size_t)(u.pm * BM + ai * HALF + wr * 64 + m * 16 + fr);
                const float rs = __builtin_amdgcn_rsqf(ss[row] * (1.0f / DM) + EPS);
                float o[8];
#pragma unroll
                for (int n = 0; n < 2; ++n)
#pragma unroll
                    for (int i = 0; i < 4; ++i) { const float g = acc[ai][0][m][n][i] * rs, uu = acc[ai][1][m][n][i] * rs; o[n * 4 + i] = g * sigmoidf_(g) * uu; }
                u32x4 w; w.x = cvt_pk_bf16(o[0], o[1]); w.y = cvt_pk_bf16(o[2], o[3]); w.z = cvt_pk_bf16(o[4], o[5]); w.w = cvt_pk_bf16(o[6], o[7]);
                *(u32x4*)(H + row * DFF + col0) = w; }
    }
};
struct EpiStoreBf16T {
    static constexpr bool PERM = false, AFTER_DRAIN = false;
    bf16_t* TMP;
    __device__ __forceinline__ void operator()(const f32x4 (&acc)[2][2][4][2], const Unit& u, int wr, int wc, int fr, int fq) const {
        const int col0 = u.pn * BM + wc * 32 + 4 * fq;
#pragma unroll
        for (int ai = 0; ai < 2; ++ai)
#pragma unroll
            for (int m = 0; m < 4; ++m) { const size_t row = (size_t)(u.pm * BM + ai * HALF + wr * 64 + m * 16 + fr);
#pragma unroll
                for (int bj = 0; bj < 2; ++bj)
#pragma unroll
                    for (int n = 0; n < 2; ++n) { const f32x4 v = acc[ai][bj][m][n]; u32x2 w; w.x = cvt_pk_bf16(v[0], v[1]); w.y = cvt_pk_bf16(v[2], v[3]);
                        *(u32x2*)(TMP + row * DM + col0 + bj * HALF + n * 16) = w; } }
    }
};
struct EpiPle {
    static constexpr bool PERM = true, AFTER_DRAIN = false;
    const bf16_t* X; bf16_t* XB; const bf16_t* TMP; const float* ssin; float* ssout;
    __device__ __forceinline__ void operator()(const f32x4 (&acc)[2][2][4][2], const Unit& u, int wr, int wc, int fr, int fq) const {
        const int col0 = u.pn * BM + wc * 32 + 8 * fq;
#pragma unroll
        for (int ai = 0; ai < 2; ++ai)
#pragma unroll
            for (int mp = 0; mp < 2; ++mp) {
                u32x4 xs[2][2]; u32x4 tw[2][2]; float sv[2];
#pragma unroll
                for (int mm = 0; mm < 2; ++mm) { const int m = mp * 2 + mm; const size_t row = (size_t)(u.pm * BM + ai * HALF + wr * 64 + m * 16 + fr);
                    sv[mm] = ssin[row];
#pragma unroll
                    for (int bj = 0; bj < 2; ++bj) { const int c = col0 + bj * HALF; xs[mm][bj] = *(const u32x4*)(X + row * DM + c); tw[mm][bj] = *(const u32x4*)(TMP + row * DM + c); } }
#pragma unroll
                for (int mm = 0; mm < 2; ++mm) { const int m = mp * 2 + mm; const size_t row = (size_t)(u.pm * BM + ai * HALF + wr * 64 + m * 16 + fr); float q = 0.f;
                    const float rs = __builtin_amdgcn_rsqf(sv[mm] * (1.0f / DM) + EPS);
#pragma unroll
                    for (int bj = 0; bj < 2; ++bj) { const int c = col0 + bj * HALF;
                        f32x4 t0, t1, x0, x1; bf8_to_f32(tw[mm][bj], t0, t1); bf8_to_f32(xs[mm][bj], x0, x1);
                        const f32x4 a0 = acc[ai][bj][m][0], a1 = acc[ai][bj][m][1];
#pragma unroll
                        for (int i = 0; i < 4; ++i) { x0[i] += sigmoidf_(a0[i] * rs) * t0[i]; x1[i] += sigmoidf_(a1[i] * rs) * t1[i]; }
                        *(u32x4*)(XB + row * DM + c) = f32_to_bf8(x0, x1);
                        q += ((x0[0] * x0[0] + x0[1] * x0[1]) + (x0[2] * x0[2] + x0[3] * x0[3])) + ((x1[0] * x1[0] + x1[1] * x1[1]) + (x1[2] * x1[2] + x1[3] * x1[3])); }
                    q += __shfl_xor(q, 16); q += __shfl_xor(q, 32);
                    if (fq == 0) __hip_atomic_fetch_add(ssout + row, q, __ATOMIC_RELAXED, __HIP_MEMORY_SCOPE_AGENT); }
                asm volatile("" ::: "memory"); }
    }
};

template <class Epi, class Sched, bool ALIGN_EPI = false, bool SP2 = false, int KREP = 1>
__device__ __forceinline__ void gemm_phase(LAS unsigned char* lds, const Gemm g, const Sched& S, const Epi& E) {
    int tid_ = threadIdx.x; asm volatile("" : "+v"(tid_));
    const int tid = tid_, wid = __builtin_amdgcn_readfirstlane(tid >> 6), lane = tid & 63, wr = wid >> 2, wc = wid & 3, fr = lane & 15, fq = lane >> 4;
    const int K = g.K, nt = K / BK;
    unsigned voffA[2], voffB[2];
#pragma unroll
    for (int i = 0; i < 2; ++i) { int R, C; stage_rc(tid * 16 + i * 8192, R, C); const int Rb = Epi::PERM ? ((R & ~31) + perm32(R & 31)) : R;
        voffA[i] = (unsigned)(R * K + C) * 2u; voffB[i] = (unsigned)(Rb * K + C) * 2u; }
    const size_t kstep = (size_t)(BK * 2);
    const size_t hstep = (size_t)HALF * K * 2;
    const size_t tstep = 2 * hstep;
    const unsigned ldsw = (unsigned)wid * 1024u;
    const int aoff = lds_byte(wr * 64 + fr, fq * 8), boff = lds_byte(wc * 32 + fr, fq * 8);
#define PG8_SA(b, h) (((b) * 2 + (h)) * HTB)
#define PG8_SB(b, h) ((4 + (b) * 2 + (h)) * HTB)
#define PG8_STAGE(bufoff, gbase, voff) do { _Pragma("unroll") for (int _i = 0; _i < 2; ++_i) \
        __builtin_amdgcn_global_load_lds((const unsigned*)((const char*)(gbase) + (voff)[_i]), (LAS unsigned*)(lds + (bufoff) + ldsw + _i * 8192), 16, 0, 0); } while (0)
#define PG8_LDA(dst, b, h) do { _Pragma("unroll") for (int m = 0; m < 4; ++m) _Pragma("unroll") for (int k = 0; k < 2; ++k) dst[m][k] = *(const LAS bf16x8*)(lds + PG8_SA(b, h) + aoff + m * 2048 + k * 1024); } while (0)
#define PG8_LDB(dst, b, h) do { _Pragma("unroll") for (int n = 0; n < 2; ++n) _Pragma("unroll") for (int k = 0; k < 2; ++k) dst[n][k] = *(const LAS bf16x8*)(lds + PG8_SB(b, h) + boff + n * 2048 + k * 1024); } while (0)
#define PG8_MMA(ai, bj, At, Bt) do { __builtin_amdgcn_s_setprio(1); _Pragma("unroll") for (int m = 0; m < 4; ++m) _Pragma("unroll") for (int n = 0; n < 2; ++n) _Pragma("unroll") for (int k = 0; k < 2; ++k) \
        acc[ai][bj][m][n] = __builtin_amdgcn_mfma_f32_16x16x32_bf16(Bt[n][k], At[m][k], acc[ai][bj][m][n], 0, 0, 0); __builtin_amdgcn_s_setprio(0); } while (0)
#define PG8_WAIT_V(n) asm volatile("s_waitcnt vmcnt(" #n ")" ::: "memory")
#define PG8_WAIT_L(n) asm volatile("s_waitcnt lgkmcnt(" #n ")" ::: "memory")
#define PG8_BAR __builtin_amdgcn_s_barrier()
#define PG8_SCHED __builtin_amdgcn_sched_barrier(0)
    Unit cur, nxt; int ui = 0;
    if (!S.next(0, cur)) return;
    f32x4 acc[2][2][4][2];
#pragma unroll
    for (int a = 0; a < 2; ++a)
#pragma unroll
        for (int b = 0; b < 2; ++b)
#pragma unroll
            for (int m = 0; m < 4; ++m)
#pragma unroll
                for (int n = 0; n < 2; ++n) acc[a][b][m][n] = (f32x4){0.f, 0.f, 0.f, 0.f};
    bf16x8 At[4][2], B0[2][2], B1[2][2];
    const char* cA = (const char*)g.A + (size_t)cur.pm * tstep; const char* cB = (const char*)g.Bt + (size_t)cur.pn * tstep;
    S.a_ready(cur);
    if constexpr (SP2) {
        PG8_STAGE(PG8_SB(0, 0), cB, voffB); PG8_STAGE(PG8_SB(0, 1), cB + hstep, voffB); PG8_STAGE(PG8_SA(0, 0), cA, voffA); PG8_STAGE(PG8_SA(0, 1), cA + hstep, voffA);
        if (wr == 1) PG8_BAR;
        PG8_WAIT_V(2); PG8_BAR;
        PG8_STAGE(PG8_SB(1, 0), cB + kstep, voffB); PG8_STAGE(PG8_SA(1, 0), cA + kstep, voffA); PG8_STAGE(PG8_SB(1, 1), cB + hstep + kstep, voffB);
        PG8_WAIT_V(6); PG8_BAR;
    } else {
        PG8_STAGE(PG8_SB(0, 0), cB, voffB); PG8_STAGE(PG8_SA(0, 0), cA, voffA); PG8_STAGE(PG8_SB(0, 1), cB + hstep, voffB); PG8_STAGE(PG8_SA(0, 1), cA + hstep, voffA);
        if (wr == 1) PG8_BAR;
        PG8_WAIT_V(4); PG8_BAR;
        PG8_STAGE(PG8_SB(1, 0), cB + kstep, voffB); PG8_STAGE(PG8_SA(1, 0), cA + kstep, voffA); PG8_STAGE(PG8_SB(1, 1), cB + hstep + kstep, voffB);
        PG8_WAIT_V(6); PG8_BAR;
    }
    for (;;) {
        const bool has_next = S.next(ui + 1, nxt);
        const char* nA = has_next ? (const char*)g.A + (size_t)nxt.pm * tstep : cA; const char* nB = has_next ? (const char*)g.Bt + (size_t)nxt.pn * tstep : cB;
        for (int t = 0; t < nt * KREP; t += 2) {
            const bool last = (t == nt * KREP - 2);
            const int t1 = (KREP == 1) ? t + 1 : ((t + 1) & (nt - 1)), t2 = (KREP == 1) ? t + 2 : ((t + 2) & (nt - 1));
            const char* a1 = cA + (size_t)t1 * kstep;
            const char* a2 = last ? nA : cA + (size_t)t2 * kstep; const char* b2 = last ? nB : cB + (size_t)t2 * kstep;
            const char* a3 = a2 + kstep; const char* b3 = b2 + kstep;
            if (last && has_next) S.a_ready(nxt);
            if constexpr (SP2) {
            PG8_LDB(B0, 0, 0); PG8_LDB(B1, 0, 1); PG8_SCHED; PG8_LDA(At, 0, 0); PG8_STAGE(PG8_SA(1, 1), a1 + hstep, voffA);
            PG8_WAIT_V(8); PG8_WAIT_L(0); PG8_BAR; PG8_MMA(0, 0, At, B0); PG8_MMA(0, 1, At, B1); PG8_BAR; PG8_SCHED;
            PG8_LDA(At, 0, 1); PG8_STAGE(PG8_SB(0, 0), b2, voffB); PG8_STAGE(PG8_SB(0, 1), b2 + hstep, voffB); PG8_STAGE(PG8_SA(0, 0), a2, voffA);
            PG8_WAIT_V(8); PG8_WAIT_L(0); PG8_BAR; PG8_MMA(1, 0, At, B0); PG8_MMA(1, 1, At, B1); PG8_BAR; PG8_SCHED;
            PG8_LDB(B0, 1, 0); PG8_LDB(B1, 1, 1); PG8_SCHED; PG8_LDA(At, 1, 0); PG8_STAGE(PG8_SA(0, 1), a2 + hstep, voffA);
            PG8_WAIT_V(8); PG8_WAIT_L(0); PG8_BAR; PG8_MMA(0, 0, At, B0); PG8_MMA(0, 1, At, B1); PG8_BAR; PG8_SCHED;
            PG8_LDA(At, 1, 1); PG8_STAGE(PG8_SB(1, 0), b3, voffB); PG8_STAGE(PG8_SB(1, 1), b3 + hstep, voffB); PG8_STAGE(PG8_SA(1, 0), a3, voffA);
            PG8_WAIT_V(8); PG8_WAIT_L(0); PG8_BAR; PG8_MMA(1, 0, At, B0); PG8_MMA(1, 1, At, B1); PG8_BAR; PG8_SCHED;
            } else {
            PG8_LDB(B0, 0, 0); PG8_SCHED; PG8_LDA(At, 0, 0); PG8_STAGE(PG8_SA(1, 1), a1 + hstep, voffA);
            PG8_WAIT_L(8); PG8_BAR; PG8_WAIT_L(0); PG8_MMA(0, 0, At, B0); PG8_BAR; PG8_SCHED;
            PG8_LDB(B1, 0, 1); PG8_STAGE(PG8_SB(0, 0), b2, voffB);
            PG8_BAR; PG8_WAIT_L(0); PG8_MMA(0, 1, At, B1); PG8_BAR;
            PG8_LDA(At, 0, 1); PG8_STAGE(PG8_SA(0, 0), a2, voffA);
            PG8_BAR; PG8_WAIT_L(0); PG8_MMA(1, 0, At, B0); PG8_BAR; PG8_SCHED;
            PG8_STAGE(PG8_SB(0, 1), b2 + hstep, voffB);
            PG8_WAIT_V(6); PG8_BAR; PG8_MMA(1, 1, At, B1); PG8_BAR;
            PG8_LDB(B0, 1, 0); PG8_SCHED; PG8_LDA(At, 1, 0); PG8_STAGE(PG8_SA(0, 1), a2 + hstep, voffA);
            PG8_WAIT_L(8); PG8_BAR; PG8_WAIT_L(0); PG8_MMA(0, 0, At, B0); PG8_BAR; PG8_SCHED;
            PG8_LDB(B1, 1, 1); PG8_STAGE(PG8_SB(1, 0), b3, voffB);
            PG8_BAR; PG8_WAIT_L(0); PG8_MMA(0, 1, At, B1); PG8_BAR;
            PG8_LDA(At, 1, 1); PG8_STAGE(PG8_SA(1, 0), a3, voffA);
            PG8_BAR; PG8_WAIT_L(0); PG8_MMA(1, 0, At, B0); PG8_BAR; PG8_SCHED;
            PG8_STAGE(PG8_SB(1, 1), b3 + hstep, voffB);
            PG8_WAIT_V(6); PG8_BAR; PG8_MMA(1, 1, At, B1); PG8_BAR;
            }
        }
        if constexpr (ALIGN_EPI) { if (wr == 0) PG8_BAR; }
        if constexpr (!Epi::AFTER_DRAIN) { E(acc, cur, wr, wc, fr, fq); S.done(cur); }
        if (!has_next) break;
#pragma unroll
        for (int a = 0; a < 2; ++a)
#pragma unroll
            for (int b = 0; b < 2; ++b)
#pragma unroll
                for (int m = 0; m < 4; ++m)
#pragma unroll
                    for (int n = 0; n < 2; ++n) acc[a][b][m][n] = (f32x4){0.f, 0.f, 0.f, 0.f};
        cur = nxt; cA = nA; cB = nB; ++ui;
        if constexpr (ALIGN_EPI) { if (wr == 1) PG8_BAR; }
    }
    PG8_WAIT_V(0);
    if constexpr (!ALIGN_EPI) { if (wr == 0) PG8_BAR; }
    PG8_BAR;
#undef PG8_SA
#undef PG8_SB
#undef PG8_STAGE
#undef PG8_LDA
#undef PG8_LDB
#undef PG8_MMA
#undef PG8_WAIT_V
#undef PG8_WAIT_L
#undef PG8_BAR
#undef PG8_SCHED
}
}

__device__ __forceinline__ unsigned f2bf(float f) { unsigned u = __builtin_bit_cast(unsigned, f); return (u + 0x7fffu + ((u >> 16) & 1u)) >> 16; }
__device__ __forceinline__ unsigned pk2(float lo, float hi) { return f2bf(lo) | (f2bf(hi) << 16); }
__device__ __forceinline__ float wave_sum(float v) {
#pragma unroll
    for (int o = 1; o < 64; o <<= 1) v += __shfl_xor(v, o);
    return v;
}
__device__ __forceinline__ void tr_item(const float* W, int K, int ldw, int col0, int ncols, bf16_t* WT, int dst_row0, bool ffmap, const float* gain  , LAS float* scr, int item, int lane) {
    const int nblk = ncols / 64, kb = item / nblk, nb = item % nblk, k0 = 64 * kb, n0 = 64 * nb;
    const int kr = lane >> 4, nc = lane & 15;
    const float* src = W + (size_t)(k0 + kr) * ldw + col0 + n0 + 4 * nc;
    f32x4 v[16];
#pragma unroll
    for (int i = 0; i < 16; ++i) v[i] = *(const f32x4*)(src + (size_t)(4 * i) * ldw);
    if (gain) {
#pragma unroll
        for (int i = 0; i < 16; ++i) v[i] = v[i] * gain[k0 + 4 * i + kr];
    }
#pragma unroll
    for (int i = 0; i < 16; ++i) { LAS float* d = scr + (4 * i + kr) * 65 + 4 * nc; d[0] = v[i].x; d[1] = v[i].y; d[2] = v[i].z; d[3] = v[i].w; }
    asm volatile("s_waitcnt lgkmcnt(0)" ::: "memory");
    int rbase;
    if (ffmap) { int j = n0; int isu = 0; if (j >= DFF) { j -= DFF; isu = 128; } rbase = 256 * (j >> 7) + isu + (j & 127); }
    else rbase = dst_row0 + n0;
    const int c = lane & 7;
#pragma unroll
    for (int j = 0; j < 8; ++j) { const int n = (lane >> 3) + 8 * j; const LAS float* sp = scr + (8 * c) * 65 + n;
        u32x4 o; o.x = pg8::cvt_pk_bf16(sp[0 * 65], sp[1 * 65]); o.y = pg8::cvt_pk_bf16(sp[2 * 65], sp[3 * 65]); o.z = pg8::cvt_pk_bf16(sp[4 * 65], sp[5 * 65]); o.w = pg8::cvt_pk_bf16(sp[6 * 65], sp[7 * 65]);
        *(u32x4*)(WT + (size_t)(rbase + n) * K + k0 + 8 * c) = o; }
    asm volatile("s_waitcnt lgkmcnt(0)" ::: "memory");
}
__device__ __forceinline__ void x_row_to_bf16(const float* xrow, bf16_t* orow, int lane) {
    const f32x4* xr = (const f32x4*)xrow + lane;
    f32x4 v[8]; float s = 0.f;
#pragma unroll
    for (int j = 0; j < 8; ++j) { v[j] = xr[64 * j]; s += (v[j].x * v[j].x + v[j].y * v[j].y) + (v[j].z * v[j].z + v[j].w * v[j].w); }
    const float rs = 1.0f / sqrtf(wave_sum(s) * (1.0f / DM) + EPS);
    u32x2* o8 = (u32x2*)orow + lane;
#pragma unroll
    for (int j = 0; j < 8; ++j) { const f32x4 y = v[j] * rs; u32x2 w; w.x = pg8::cvt_pk_bf16(y.x, y.y); w.y = pg8::cvt_pk_bf16(y.z, y.w); o8[64 * j] = w; }
}

__device__ __forceinline__ int pi32(int i) { const int g = (i >> 2) & 3; const int g2 = (g == 1) ? 2 : ((g == 2) ? 1 : g); return (i & 16) | (g2 << 2) | (i & 3); }
__device__ __forceinline__ unsigned cvtpk(float lo, float hi) { unsigned r; asm volatile("v_cvt_pk_bf16_f32 %0, %1, %2" : "=v"(r) : "v"(lo), "v"(hi)); return r; }
#define MFMA32(a, b, c) __builtin_amdgcn_mfma_f32_32x32x16_bf16((a), (b), (c), 0, 0, 0)

struct AttnTile {
    LAS unsigned char* wl;
    const bf16_t* kb; const bf16_t* vb;
    unsigned kgo[4];
    unsigned vgo;
    int kro, vro0, vro1;
};
__device__ __forceinline__ void attn_tile_init(AttnTile& T, LAS unsigned char* wl, const bf16_t* Kbase  , const bf16_t* Vbase  , int lane) {
    T.wl = wl; T.kb = Kbase; T.vb = Vbase;
    const int l4 = lane >> 4, c0 = lane & 15;
#pragma unroll
    for (int g = 0; g < 4; ++g) T.kgo[g] = (unsigned)(l4 * QKP + ((c0 ^ (4 * g + l4)) * 8));
    const int vr = lane >> 2, vc = (lane & 3) ^ ((vr >> 2) & 3);
    T.vgo = (unsigned)(vr * 32 + vc * 8);
    const int r32 = lane & 31, hi = lane >> 5, sw = (r32 >> 2) & 3;
    T.kro = r32 * 256;
    T.vro0 = 8192 + r32 * 64 + ((hi ^ sw) * 16);
    T.vro1 = 8192 + r32 * 64 + (((2 + hi) ^ sw) * 16);
}
__device__ __forceinline__ void attn_issue_k(const AttnTile& T, int sb) {
#pragma unroll
    for (int i = 0; i < 8; ++i) { const int g = i & 3; const int pi_i = (i & 4) | ((g == 1) ? 2 : ((g == 2) ? 1 : g));
        __builtin_amdgcn_global_load_lds((const unsigned*)(T.kb + (size_t)(sb + 4 * pi_i) * QKP + T.kgo[g]), (LAS unsigned*)(T.wl + i * 1024), 16, 0, 0); }
}
__device__ __forceinline__ void attn_issue_v(const AttnTile& T, int sb) {
#pragma unroll
    for (int i = 0; i < 8; ++i)
        __builtin_amdgcn_global_load_lds((const unsigned*)(T.vb + (size_t)(sb >> 5) * 65536 + (16 * i) * 32 + T.vgo), (LAS unsigned*)(T.wl + 8192 + i * 1024), 16, 0, 0);
}
__device__ __forceinline__ void attn_read_k(const AttnTile& T, bf16x8 (&kf)[8], int lane) {
    const int r15 = lane & 15, hi = lane >> 5;
#pragma unroll
    for (int ks = 0; ks < 8; ++ks) kf[ks] = *(const LAS bf16x8*)(T.wl + T.kro + (((2 * ks + hi) ^ r15) * 16));
}
__device__ __forceinline__ void attn_read_v(const AttnTile& T, bf16x8 (&vf)[4][2]) {
#pragma unroll
    for (int d = 0; d < 4; ++d) { vf[d][0] = *(const LAS bf16x8*)(T.wl + T.vro0 + d * 2048); vf[d][1] = *(const LAS bf16x8*)(T.wl + T.vro1 + d * 2048); }
}
__device__ __forceinline__ void attn_store_o(const AttnTile& T, const f32x16 (&o)[4], float scale, bf16_t* Yrow0  , int lane) {
    const int r32 = lane & 31, hi = lane >> 5;
#pragma unroll
    for (int d = 0; d < 4; ++d)
#pragma unroll
        for (int g = 0; g < 4; ++g) { u32x2 w; w.x = cvtpk(o[d][4 * g] * scale, o[d][4 * g + 1] * scale); w.y = cvtpk(o[d][4 * g + 2] * scale, o[d][4 * g + 3] * scale);
            *(LAS u32x2*)(T.wl + r32 * 256 + (((4 * d + g) ^ (r32 & 15)) * 16) + hi * 8) = w; }
    asm volatile("s_waitcnt lgkmcnt(0)" ::: "memory");
    const int l4 = lane >> 4, cs = lane & 15;
#pragma unroll
    for (int i = 0; i < 8; ++i) { const int row = 4 * i + l4; const u32x4 v = *(const LAS u32x4*)(T.wl + row * 256 + cs * 16);
        *(u32x4*)(Yrow0 + (size_t)row * 1024 + ((cs ^ (row & 15)) * 8)) = v; }
    asm volatile("s_waitcnt lgkmcnt(0)" ::: "memory");
}

__device__ __forceinline__ void sb_unit(const bf16_t* __restrict__ QK, const bf16_t* __restrict__ VT, bf16_t* __restrict__ Y, LAS unsigned char* wl, int b, int h, int qb, int lane) {
    const int r32 = lane & 31, hi = lane >> 5, t0 = qb * 32, q = t0 + r32;
    const size_t rowbase = (size_t)b * SEQ;
    AttnTile T; attn_tile_init(T, wl, QK + rowbase * QKP + 1024 + h * HD, VT + (size_t)b * (SEQ / 32) * 65536 + (size_t)(h * HD) * 32, lane);
    const bf16_t* Qp = QK + (rowbase + q) * QKP + h * HD + 8 * hi;
    bf16x8 qf[8];
#pragma unroll
    for (int ks = 0; ks < 8; ++ks) qf[ks] = *(const bf16x8*)(Qp + 16 * ks);
    attn_issue_k(T, t0); attn_issue_v(T, t0);
    f32x16 o[4];
#pragma unroll
    for (int d = 0; d < 4; ++d)
#pragma unroll
        for (int r = 0; r < 16; ++r) o[d][r] = 0.f;
    float carry = 1.0f;
    for (int sb = t0; sb >= 0; sb -= 32) {
        bf16x8 kf[8];
        asm volatile("s_waitcnt vmcnt(8)" ::: "memory");
        attn_read_k(T, kf, lane);
        asm volatile("s_waitcnt lgkmcnt(0)" ::: "memory");
        const bool more = sb > 0;
        if (more) attn_issue_k(T, sb - 32);
        f32x16 s;
#pragma unroll
        for (int r = 0; r < 16; ++r) s[r] = 0.f;
#pragma unroll
        for (int ks = 0; ks < 8; ++ks) s = MFMA32(kf[ks], qf[ks], s);
        float u[16];
#pragma unroll
        for (int r = 0; r < 16; ++r) u[r] = __builtin_amdgcn_rcpf(1.0f + __builtin_amdgcn_exp2f(s[r]));
        if (sb == t0) {
#pragma unroll
            for (int r = 0; r < 16; ++r) { const int key = sb + 16 * (r >> 3) + 8 * hi + (r & 7); u[r] = (key < q) ? u[r] : 1.0f; }
        }
        float S[16];
        S[7] = u[7]; S[15] = u[15];
#pragma unroll
        for (int r = 6; r >= 0; --r) { S[r] = u[r] * S[r + 1]; S[r + 8] = u[r + 8] * S[r + 9]; }
        const float TA = S[0], TB = S[8];
        const float pTA = __shfl_xor(TA, 32), pTB = __shfl_xor(TB, 32);
        const float offB = hi ? carry : carry * pTB;
        const float offA = (carry * TB) * (hi ? pTB : pTB * pTA);
        float a[16];
#pragma unroll
        for (int r = 0; r < 16; ++r) { const float ex = ((r & 7) == 7) ? 1.0f : S[r + 1]; a[r] = (1.0f - u[r]) * (ex * ((r < 8) ? offA : offB)); }
        carry *= (TA * TB) * (pTA * pTB);
        u32x4 p0, p1;
        p0.x = cvtpk(a[0], a[1]); p0.y = cvtpk(a[2], a[3]); p0.z = cvtpk(a[4], a[5]); p0.w = cvtpk(a[6], a[7]);
        p1.x = cvtpk(a[8], a[9]); p1.y = cvtpk(a[10], a[11]); p1.z = cvtpk(a[12], a[13]); p1.w = cvtpk(a[14], a[15]);
        const bf16x8 pb0 = __builtin_bit_cast(bf16x8, p0), pb1 = __builtin_bit_cast(bf16x8, p1);
        bf16x8 vf[4][2];
        if (more) asm volatile("s_waitcnt vmcnt(8)" ::: "memory"); else asm volatile("s_waitcnt vmcnt(0)" ::: "memory");
        attn_read_v(T, vf);
        asm volatile("s_waitcnt lgkmcnt(0)" ::: "memory");
        if (more) attn_issue_v(T, sb - 32);
#pragma unroll
        for (int d = 0; d < 4; ++d) { o[d] = MFMA32(vf[d][0], pb0, o[d]); o[d] = MFMA32(vf[d][1], pb1, o[d]); }
        if (!__any(carry > 1e-36f)) break;
    }
    asm volatile("s_waitcnt vmcnt(0)" ::: "memory");
    attn_store_o(T, o, 1.0f, Y + (rowbase + t0) * 1024 + h * HD, lane);
}
__device__ __forceinline__ void ca_unit(const bf16_t* __restrict__ QK, const bf16_t* __restrict__ VT, bf16_t* __restrict__ Y, const LAS float* bias, LAS unsigned char* wl, int b, int h, int qb, int lane) {
    const int r32 = lane & 31, hi = lane >> 5, t0 = qb * 32, q = t0 + r32;
    const int ch = qb >> 1; const int kstart = (ch >= 8) ? 64 * (ch - 8) : 0, kend = 64 * (ch + 1);
    const size_t rowbase = (size_t)b * SEQ;
    AttnTile T; attn_tile_init(T, wl, QK + rowbase * QKP + 3072 + h * HD, VT + (size_t)b * (SEQ / 32) * 65536 + (size_t)(1024 + h * HD) * 32, lane);
    const bf16_t* Qp = QK + (rowbase + q) * QKP + 2048 + h * HD + 8 * hi;
    bf16x8 qf[8];
#pragma unroll
    for (int ks = 0; ks < 8; ++ks) qf[ks] = *(const bf16x8*)(Qp + 16 * ks);
    attn_issue_k(T, kstart); attn_issue_v(T, kstart);
    const LAS float* bh = bias + h * NREL;
    f32x16 o[4];
#pragma unroll
    for (int d = 0; d < 4; ++d)
#pragma unroll
        for (int r = 0; r < 16; ++r) o[d][r] = 0.f;
    float mrun = -1e30f, lsum = 0.f;
    for (int sb = kstart; sb < kend; sb += 32) {
        bf16x8 kf[8];
        asm volatile("s_waitcnt vmcnt(8)" ::: "memory");
        attn_read_k(T, kf, lane);
        asm volatile("s_waitcnt lgkmcnt(0)" ::: "memory");
        const bool more = sb + 32 < kend;
        if (more) attn_issue_k(T, sb + 32);
        f32x16 s;
#pragma unroll
        for (int r = 0; r < 16; ++r) s[r] = 0.f;
#pragma unroll
        for (int ks = 0; ks < 8; ++ks) s = MFMA32(kf[ks], qf[ks], s);
        float mx = -1e30f;
        if (sb + 31 - t0 <= -128) {
            const float b0 = bh[0];
#pragma unroll
            for (int r = 0; r < 16; ++r) { s[r] += b0; mx = fmaxf(mx, s[r]); }
        } else {
#pragma unroll
            for (int r = 0; r < 16; ++r) { const int rel = sb + 16 * (r >> 3) + 8 * hi + (r & 7) - q; const int idx = min(max(rel, -128), 63) + 128;
                s[r] += bh[idx]; mx = fmaxf(mx, s[r]); }
        }
        mx = fmaxf(mx, __shfl_xor(mx, 32));
        const float mnew = fmaxf(mrun, mx); const float alpha = __builtin_amdgcn_exp2f(mrun - mnew); mrun = mnew;
        float a[16]; float ps = 0.f;
#pragma unroll
        for (int r = 0; r < 16; ++r) { a[r] = __builtin_amdgcn_exp2f(s[r] - mnew); ps += a[r]; }
        lsum = lsum * alpha + ps;
        if (__any(alpha != 1.0f)) {
#pragma unroll
            for (int d = 0; d < 4; ++d)
#pragma unroll
                for (int r = 0; r < 16; ++r) o[d][r] *= alpha;
        }
        u32x4 p0, p1;
        p0.x = cvtpk(a[0], a[1]); p0.y = cvtpk(a[2], a[3]); p0.z = cvtpk(a[4], a[5]); p0.w = cvtpk(a[6], a[7]);
        p1.x = cvtpk(a[8], a[9]); p1.y = cvtpk(a[10], a[11]); p1.z = cvtpk(a[12], a[13]); p1.w = cvtpk(a[14], a[15]);
        const bf16x8 pb0 = __builtin_bit_cast(bf16x8, p0), pb1 = __builtin_bit_cast(bf16x8, p1);
        bf16x8 vf[4][2];
        if (more) asm volatile("s_waitcnt vmcnt(8)" ::: "memory"); else asm volatile("s_waitcnt vmcnt(0)" ::: "memory");
        attn_read_v(T, vf);
        asm volatile("s_waitcnt lgkmcnt(0)" ::: "memory");
        if (more) attn_issue_v(T, sb + 32);
#pragma unroll
        for (int d = 0; d < 4; ++d) { o[d] = MFMA32(vf[d][0], pb0, o[d]); o[d] = MFMA32(vf[d][1], pb1, o[d]); }
    }
    lsum += __shfl_xor(lsum, 32);
    const float inv = 1.0f / lsum;
    attn_store_o(T, o, inv, Y + (rowbase + t0) * 1024 + h * HD, lane);
}

__device__ __forceinline__ void ca_wg_unit(const bf16_t* __restrict__ QK, const bf16_t* __restrict__ VT, bf16_t* __restrict__ Y, const LAS float* bias, LAS unsigned char* lds, int b, int h, int g, int wave, int lane) {
    constexpr int NS = 4;
    const int r32 = lane & 31, hi = lane >> 5, t0 = 256 * g + 32 * wave, q = t0 + r32;
    const int ch = 4 * g + (wave >> 1);
    const int kmin = (g >= 2) ? 64 * (4 * g - 8) : 0;
    const int ntiles = (64 * (4 * g + 4) - kmin) >> 5;
    const int klo = (ch >= 8) ? 64 * (ch - 8) : 0, khi = 64 * (ch + 1);
    const int tlo = (klo - kmin) >> 5, thi = (khi - kmin) >> 5;
    const size_t rowbase = (size_t)b * SEQ;
    const bf16_t* Qp = QK + (rowbase + q) * QKP + 2048 + h * HD + 8 * hi;
    bf16x8 qf[8];
#pragma unroll
    for (int ks = 0; ks < 8; ++ks) qf[ks] = *(const bf16x8*)(Qp + 16 * ks);
    const int l4 = lane >> 4, c0 = lane & 15, gq = wave & 3, pi_w = (wave & 4) | ((gq == 1) ? 2 : ((gq == 2) ? 1 : gq));
    const bf16_t* ksrc = QK + (rowbase + kmin + 4 * pi_w + l4) * QKP + 3072 + h * HD + ((c0 ^ (4 * gq + l4)) * 8);
    const int vr = lane >> 2, vc = (lane & 3) ^ ((vr >> 2) & 3);
    const bf16_t* vsrc = VT + ((size_t)b * (SEQ / 32) + (kmin >> 5)) * 65536 + (size_t)(1024 + h * HD + 16 * wave + vr) * 32 + vc * 8;
    LAS unsigned char* kdst = lds + wave * 1024; LAS unsigned char* vdst = lds + 8192 + wave * 1024;
#define CAW_ISSUE(tile, slot) do { __builtin_amdgcn_global_load_lds((const unsigned*)(ksrc + (size_t)(tile) * 32 * QKP), (LAS unsigned*)(kdst + (slot) * 16384), 16, 0, 0); \
        __builtin_amdgcn_global_load_lds((const unsigned*)(vsrc + (size_t)(tile) * 65536), (LAS unsigned*)(vdst + (slot) * 16384), 16, 0, 0); } while (0)
    const int kro = r32 * 256, r15 = lane & 15, sw = (r32 >> 2) & 3;
    const int vro0 = 8192 + r32 * 64 + ((hi ^ sw) * 16), vro1 = 8192 + r32 * 64 + (((2 + hi) ^ sw) * 16);
    const LAS float* bh = bias + h * NREL;
    f32x16 o[4];
#pragma unroll
    for (int d = 0; d < 4; ++d)
#pragma unroll
        for (int r = 0; r < 16; ++r) o[d][r] = 0.f;
    float mrun = -1e30f, lsum = 0.f;
    CAW_ISSUE(0, 0); CAW_ISSUE(1, 1); CAW_ISSUE(2, 2);
    for (int tau = 0; tau < ntiles; ++tau) {
        asm volatile("s_waitcnt vmcnt(4) lgkmcnt(0)\n\ts_barrier" ::: "memory");
        { const int nx = (tau + 3 < ntiles) ? tau + 3 : ntiles - 1; const int sl = (tau + 3) & 3; CAW_ISSUE(nx, sl); }
        if (tau >= tlo && tau < thi) {
            const int sb = kmin + 32 * tau;
            LAS unsigned char* wl = lds + (tau & 3) * 16384;
            bf16x8 kf[8];
#pragma unroll
            for (int ks = 0; ks < 8; ++ks) kf[ks] = *(const LAS bf16x8*)(wl + kro + (((2 * ks + hi) ^ r15) * 16));
            f32x16 s;
#pragma unroll
            for (int r = 0; r < 16; ++r) s[r] = 0.f;
#pragma unroll
            for (int ks = 0; ks < 8; ++ks) s = MFMA32(kf[ks], qf[ks], s);
            float mx = -1e30f, badd = 0.f;
            if (sb + 31 - t0 <= -128) {
#pragma unroll
                for (int r = 0; r < 16; ++r) mx = fmaxf(mx, s[r]);
                badd = bh[0]; mx += badd;
            } else {
#pragma unroll
                for (int r = 0; r < 16; ++r) { const int rel = sb + 16 * (r >> 3) + 8 * hi + (r & 7) - q; const int idx = min(max(rel, -128), 63) + 128;
                    s[r] += bh[idx]; mx = fmaxf(mx, s[r]); }
            }
            mx = fmaxf(mx, __shfl_xor(mx, 32));
            const float mnew = fmaxf(mrun, mx); const float alpha = __builtin_amdgcn_exp2f(mrun - mnew); mrun = mnew;
            const float sh = badd - mnew;
            float a[16]; float ps = 0.f;
#pragma unroll
            for (int r = 0; r < 16; ++r) { a[r] = __builtin_amdgcn_exp2f(s[r] + sh); ps += a[r]; }
            lsum = lsum * alpha + ps;
            if (__any(alpha != 1.0f)) {
#pragma unroll
                for (int d = 0; d < 4; ++d)
#pragma unroll
                    for (int r = 0; r < 16; ++r) o[d][r] *= alpha;
            }
            u32x4 p0, p1;
            p0.x = cvtpk(a[0], a[1]); p0.y = cvtpk(a[2], a[3]); p0.z = cvtpk(a[4], a[5]); p0.w = cvtpk(a[6], a[7]);
            p1.x = cvtpk(a[8], a[9]); p1.y = cvtpk(a[10], a[11]); p1.z = cvtpk(a[12], a[13]); p1.w = cvtpk(a[14], a[15]);
            const bf16x8 pb0 = __builtin_bit_cast(bf16x8, p0), pb1 = __builtin_bit_cast(bf16x8, p1);
            bf16x8 vf[4][2];
#pragma unroll
            for (int d = 0; d < 4; ++d) { vf[d][0] = *(const LAS bf16x8*)(wl + vro0 + d * 2048); vf[d][1] = *(const LAS bf16x8*)(wl + vro1 + d * 2048); }
#pragma unroll
            for (int d = 0; d < 4; ++d) { o[d] = MFMA32(vf[d][0], pb0, o[d]); o[d] = MFMA32(vf[d][1], pb1, o[d]); }
        }
    }
#undef CAW_ISSUE
    asm volatile("s_waitcnt vmcnt(0) lgkmcnt(0)\n\ts_barrier" ::: "memory");
    lsum += __shfl_xor(lsum, 32);
    const float inv = 1.0f / lsum;
    AttnTile T; T.wl = lds + 65536 + wave * 8192;
    attn_store_o(T, o, inv, Y + (rowbase + t0) * 1024 + h * HD, lane);
    asm volatile("s_waitcnt vmcnt(0)" ::: "memory");
}

__device__ __forceinline__ int fresh_tid() { int t = threadIdx.x; asm volatile("" : "+v"(t)); return t; }
#define XB_TMO      128
#define XB_XCNT(j)  (256  + 64 * (j))
#define XB_XSUB(j)  (1280 + 64 * (j))
#define XB_XGEN(j)  (2304 + 64 * (j))
#define XB_TOP      3328
#define XB_TOPGEN   3392
#define XCD_BAR_WORDS 3456
#define XB_SPIN_CAP (1u << 18)
__device__ __forceinline__ unsigned xb_ld(unsigned* p)              { return __hip_atomic_load(p, __ATOMIC_RELAXED, __HIP_MEMORY_SCOPE_AGENT); }
__device__ __forceinline__ unsigned xb_add(unsigned* p, unsigned v) { return __hip_atomic_fetch_add(p, v, __ATOMIC_RELAXED, __HIP_MEMORY_SCOPE_AGENT); }
__device__ __forceinline__ unsigned xb_xcc_id() { return (unsigned)__builtin_amdgcn_s_getreg((3 << 11) | 20) & 0xFu; }
#define XB_SPIN(cond, bar) do { unsigned _sp = 0; while (cond) { __builtin_amdgcn_s_sleep(1); \
    if ((++_sp & 255u) == 0u) { if (xb_ld(&(bar)[XB_TMO])) break; if (_sp > XB_SPIN_CAP) { atomicAdd(&(bar)[XB_TMO], 1u); break; } } } } while (0)
struct XcdBarrier { unsigned* bar; unsigned x; volatile LAS unsigned* st; };
__device__ __forceinline__ XcdBarrier xcd_barrier_post(unsigned* bar, volatile LAS unsigned* st) {
    XcdBarrier b; b.bar = bar; b.x = xb_xcc_id(); b.st = st;
    if (fresh_tid() == 0) (void)xb_add(&bar[XB_XCNT(b.x)], 1u);
    return b;
}
__device__ __forceinline__ void xcd_barrier_complete(unsigned* bar, unsigned x, unsigned& nloc, unsigned& nx) {
    const unsigned G = gridDim.x * gridDim.y * gridDim.z;
    unsigned sum, cnt, mine, sp = 0u;
    for (;;) {
        sum = 0u; cnt = 0u; mine = 0u;
#pragma unroll
        for (unsigned j = 0; j < 16; ++j) { const unsigned c = xb_ld(&bar[XB_XCNT(j)]); sum += c; cnt += (c > 0u) ? 1u : 0u; mine = (j == x) ? c : mine; }
        if (sum == G) break;
        __builtin_amdgcn_s_sleep(1);
        if ((++sp & 255u) == 0u) { if (xb_ld(&bar[XB_TMO])) break; if (sp > XB_SPIN_CAP) { atomicAdd(&bar[XB_TMO], 1u); break; } }
    }
    nloc = mine > 0u ? mine : 1u; nx = cnt > 0u ? cnt : 1u;
}
__device__ __forceinline__ void xcd_barrier(const XcdBarrier& b, int wave  ) {
    asm volatile("s_waitcnt vmcnt(0)" ::: "memory");
    __syncthreads();
    if (wave == 0 && __builtin_amdgcn_mbcnt_hi(~0u, __builtin_amdgcn_mbcnt_lo(~0u, 0u)) == 0u) {
        unsigned* bar = b.bar;
        __builtin_amdgcn_s_waitcnt(0);
        unsigned nloc = b.st[0], nx = b.st[1];
        if (nloc == 0u) { xcd_barrier_complete(bar, b.x, nloc, nx); b.st[0] = nloc; b.st[1] = nx; }
        const unsigned old = xb_add(&bar[XB_XSUB(b.x)], 1u);
        const unsigned gen = old / nloc;
        if (old + 1u == (gen + 1u) * nloc) {
            __builtin_amdgcn_fence(__ATOMIC_RELEASE, "agent");
            asm volatile("s_waitcnt vmcnt(0)" ::: "memory");
            const unsigned og = xb_add(&bar[XB_TOP], 1u);
            const unsigned tg = og / nx;
            if (og + 1u == (tg + 1u) * nx) xb_add(&bar[XB_TOPGEN], 1u);
            else XB_SPIN(xb_ld(&bar[XB_TOPGEN]) == tg, bar);
            __builtin_amdgcn_fence(__ATOMIC_ACQUIRE, "agent");
            xb_add(&bar[XB_XGEN(b.x)], 1u);
            asm volatile("s_waitcnt vmcnt(0)" ::: "memory");
        } else {
            XB_SPIN(xb_ld(&bar[XB_XGEN(b.x)]) == gen, bar);
            __builtin_amdgcn_fence(__ATOMIC_ACQUIRE, "agent");
            asm volatile("s_waitcnt vmcnt(0)" ::: "memory");
        }
    }
    __syncthreads();
}

constexpr int NWAVES = 8;
constexpr int LDS_BYTES = 147456;
struct Args { const float* in[15]; float* out; unsigned char* ws; };

__global__ void __launch_bounds__(NWAVES * 64, 2) mega_fwd(Args args) {
    extern __shared__ __attribute__((aligned(16))) unsigned char lds_raw[];
    LAS unsigned char* lds = (LAS unsigned char*)lds_raw;
    cg::grid_group grid = cg::this_grid();
    const int tid = fresh_tid(), lane = tid & 63, wave = __builtin_amdgcn_readfirstlane(tid >> 6);
    const int G = gridDim.x, bx = blockIdx.x;
    const int gw = bx * NWAVES + wave, NGW = G * NWAVES;

    const float* x = args.in[0]; const float* p = args.in[1]; const float* w_in = args.in[2]; const float* w_sb_out = args.in[3]; const float* w_ca_out = args.in[4];
    const float* w_mix_out = args.in[5]; const float* rel_bias = args.in[6]; const float* g_mix = args.in[7]; const float* g_ffn = args.in[8]; const float* g_ple = args.in[9];
    const float* g_final = args.in[10]; const float* w_ffn_in = args.in[11]; const float* w_ffn_out = args.in[12]; const float* w_ple_in = args.in[13]; const float* w_ple_gate = args.in[14];
    unsigned char* ws = args.ws; float* out = args.out;
    bf16_t* WINA = (bf16_t*)(ws + WS_WINA); bf16_t* WINV = (bf16_t*)(ws + WS_WINV); bf16_t* WSB = (bf16_t*)(ws + WS_WSB); bf16_t* WCA = (bf16_t*)(ws + WS_WCA);
    bf16_t* WMIX = (bf16_t*)(ws + WS_WMIX); bf16_t* WFI = (bf16_t*)(ws + WS_WFI); bf16_t* WFO = (bf16_t*)(ws + WS_WFO); bf16_t* WPI = (bf16_t*)(ws + WS_WPI); bf16_t* WPG = (bf16_t*)(ws + WS_WPG);
    bf16_t* PBF = (bf16_t*)(ws + WS_PBF); float* SS = (float*)(ws + WS_SS);
    bf16_t* R1 = (bf16_t*)(ws + WS_R1); bf16_t* GB = (bf16_t*)(ws + WS_G); bf16_t* XN = (bf16_t*)(ws + WS_XN); bf16_t* HB = (bf16_t*)(ws + WS_H);
    bf16_t* QK = (bf16_t*)(ws + WS_QK); bf16_t* TMP = (bf16_t*)(ws + WS_QK); bf16_t* TMP2 = (bf16_t*)(ws + WS_R1);
    bf16_t* VT = (bf16_t*)out; bf16_t* YSB = (bf16_t*)((unsigned char*)out + 64 * MiB); bf16_t* YCA = (bf16_t*)((unsigned char*)out + 96 * MiB);
    float* ss1 = SS; float* ss2 = SS + MTOK; float* ss3 = SS + 2 * MTOK;
    bf16_t* XB = (bf16_t*)(ws + WS_QK + 64 * MiB);
    volatile LAS unsigned* bst = (volatile LAS unsigned*)(lds + LDS_BYTES - 64);
    if (tid < 2) bst[tid] = 0u;
    __syncthreads();
    (void)xcd_barrier_post((unsigned*)(ws + WS_CTL), bst);
#define SEAM() do { XcdBarrier b_; b_.bar = (unsigned*)(ws + WS_CTL); b_.x = xb_xcc_id(); b_.st = bst; xcd_barrier(b_, wave); } while (0)

    for (int rep_ = 0; rep_ < 1 + XP_DUP_P0; ++rep_) {
        LAS float* scr = (LAS float*)(lds + wave * 16640);
        constexpr int I1 = (DM / 64) * (2048 / 64), I2 = (DM / 64) * (1024 / 64), I5 = (DM / 64) * (4096 / 64);
        constexpr int I6 = (1024 / 64) * (DM / 64), I8 = (DM / 64) * (DM / 64), I9 = (DM / 64) * (2 * DFF / 64), I10 = (DFF / 64) * (DM / 64), I11 = (DPLE / 64) * (DM / 64);
        constexpr int NITEMS = I1 + I2 + I1 + I2 + I5 + I6 + I6 + I8 + I9 + I10 + I11 + I8;
        for (int it = gw; it < NITEMS; it += NGW) {
            int r = it;
            if (r < I1) { tr_item(w_in, DM, INCOLS, 0, 2048, WINA, 0, false, g_mix, scr, r, lane); continue; } r -= I1;
            if (r < I2) { tr_item(w_in, DM, INCOLS, 2048, 1024, WINV, 0, false, g_mix, scr, r, lane); continue; } r -= I2;
            if (r < I1) { tr_item(w_in, DM, INCOLS, 3072, 2048, WINA, 2048, false, g_mix, scr, r, lane); continue; } r -= I1;
            if (r < I2) { tr_item(w_in, DM, INCOLS, 5120, 1024, WINV, 1024, false, g_mix, scr, r, lane); continue; } r -= I2;
            if (r < I5) { tr_item(w_in, DM, INCOLS, 6144, 4096, WINA, 4096, false, g_mix, scr, r, lane); continue; } r -= I5;
            if (r < I6) { tr_item(w_sb_out, 1024, DM, 0, DM, WSB, 0, false, nullptr, scr, r, lane); continue; } r -= I6;
            if (r < I6) { tr_item(w_ca_out, 1024, DM, 0, DM, WCA, 0, false, nullptr, scr, r, lane); continue; } r -= I6;
            if (r < I8) { tr_item(w_mix_out, DM, DM, 0, DM, WMIX, 0, false, nullptr, scr, r, lane); continue; } r -= I8;
            if (r < I9) { tr_item(w_ffn_in, DM, 2 * DFF, 0, 2 * DFF, WFI, 0, true, g_ffn, scr, r, lane); continue; } r -= I9;
            if (r < I10) { tr_item(w_ffn_out, DFF, DM, 0, DM, WFO, 0, false, nullptr, scr, r, lane); continue; } r -= I10;
            if (r < I11) { tr_item(w_ple_in, DPLE, DM, 0, DM, WPI, 0, false, nullptr, scr, r, lane); continue; } r -= I11;
            tr_item(w_ple_gate, DM, DM, 0, DM, WPG, 0, false, g_ple, scr, r, lane);
        }
        for (int m = gw; m < MTOK; m += 2 * NGW) {
            const int m1 = (m + NGW < MTOK) ? m + NGW : m;
            const f32x4* xa = (const f32x4*)(x + (size_t)m * DM) + lane; const f32x4* xb = (const f32x4*)(x + (size_t)m1 * DM) + lane;
            f32x4 va[8], vb[8]; float sa = 0.f, sb_ = 0.f;
#pragma unroll
            for (int j = 0; j < 8; ++j) { va[j] = xa[64 * j]; vb[j] = xb[64 * j]; }
#pragma unroll
            for (int j = 0; j < 8; ++j) { sa += (va[j].x * va[j].x + va[j].y * va[j].y) + (va[j].z * va[j].z + va[j].w * va[j].w); sb_ += (vb[j].x * vb[j].x + vb[j].y * vb[j].y) + (vb[j].z * vb[j].z + vb[j].w * vb[j].w); }
            const float ra = 1.0f / sqrtf(wave_sum(sa) * (1.0f / DM) + EPS), rb = 1.0f / sqrtf(wave_sum(sb_) * (1.0f / DM) + EPS);
            u32x2* oa = (u32x2*)(R1 + (size_t)m * DM) + lane; u32x2* ob = (u32x2*)(R1 + (size_t)m1 * DM) + lane;
#pragma unroll
            for (int j = 0; j < 8; ++j) { const f32x4 ya = va[j] * ra, yb = vb[j] * rb; u32x2 wa, wb; wa.x = pg8::cvt_pk_bf16(ya.x, ya.y); wa.y = pg8::cvt_pk_bf16(ya.z, ya.w); wb.x = pg8::cvt_pk_bf16(yb.x, yb.y); wb.y = pg8::cvt_pk_bf16(yb.z, yb.w);
                oa[64 * j] = wa; ob[64 * j] = wb; }
        }
        {
            const size_t n4 = (size_t)MTOK * DPLE / 4; const size_t gt = (size_t)bx * 512 + tid, GT = (size_t)G * 512;
            for (size_t i = gt; i < n4; i += GT) { const f32x4 v = ((const f32x4*)p)[i]; u32x2 w; w.x = pk2(v.x, v.y); w.y = pk2(v.z, v.w); ((u32x2*)PBF)[i] = w; }
            for (size_t i = gt; i < (size_t)3 * MTOK; i += GT) SS[i] = 0.f;
        }
    }
    if (args.ws == nullptr) grid.sync();
    SEAM();

    for (int rep_ = 0; rep_ < 1 + XP_DUP_P1; ++rep_) {
        pg8::Gemm g{R1, WINA, MTOK, 8192, DM}; pg8::StaticOrder S; S.init(MTOK, 8192, G, bx);
        pg8::EpiInProj E{QK, GB};
        pg8::gemm_phase<pg8::EpiInProj, pg8::StaticOrder, true, true, XP_KREP>(lds, g, S, E);
    }
    {
        pg8::Gemm g{WINV, R1, 2048, MTOK, DM}; pg8::StaticOrder S; S.init(2048, MTOK, G, bx);
        pg8::EpiBf16Plain E{VT, MTOK};
        pg8::gemm_phase<pg8::EpiBf16Plain, pg8::StaticOrder, true, true>(lds, g, S, E);
    }
    SEAM();

    for (int xs_ = 0; xs_ < XP_EXTRA_SYNCS; ++xs_) grid.sync();
    for (int rep_ = 0; rep_ < 1 + XP_DUP_P2; ++rep_) {
        int tid2 = threadIdx.x; asm volatile("" : "+v"(tid2)); const int lane = tid2 & 63;
        LAS float* bl = (LAS float*)(lds + 131072 + 1024);
        for (int i = tid2; i < NH * NREL; i += NWAVES * 64) bl[i] = rel_bias[i] * LOG2E;
        __syncthreads();
        const int vcu = (G % 8 == 0) ? (bx % 8) * (G / 8) + bx / 8 : bx;
        for (int i = 0, u = vcu; u < NB * NH * 8; ++i, u += G) { const int bh_ = u >> 3; int g = u & 7; if (i & 1) g = 7 - g;
            ca_wg_unit(QK, VT, YCA, bl, lds, bh_ >> 3, bh_ & 7, g, wave, lane); }
        __syncthreads();
        LAS unsigned char* wl = lds + wave * 16384;
        constexpr int NU = NB * NH * (SEQ / 32);
        for (int u = vcu * NWAVES + wave; u < NU; u += NGW) { const int qb = u & 63, h = (u >> 6) & 7, b = u >> 9; sb_unit(QK, VT, YSB, wl, b, h, qb, lane); }
    }
    SEAM();

    {
        pg8::Gemm g{YSB, WSB, MTOK, DM, 1024}; pg8::StaticOrder S; S.init(MTOK, DM, G, bx);
        pg8::EpiGate<0> E{GB, 0, TMP, R1};
        pg8::gemm_phase<pg8::EpiGate<0>, pg8::StaticOrder, true, true>(lds, g, S, E);
    }
    {
        pg8::Gemm g{YCA, WCA, MTOK, DM, 1024}; pg8::StaticOrder S; S.init(MTOK, DM, G, bx);
        pg8::EpiGate<1> E{GB, 2048, TMP, R1};
        pg8::gemm_phase<pg8::EpiGate<1>, pg8::StaticOrder, true, true>(lds, g, S, E);
    }
    SEAM();

    {
        pg8::Gemm g{R1, WMIX, MTOK, DM, DM}; pg8::StaticOrder S; S.init(MTOK, DM, G, bx);
        pg8::EpiResid<false> E{x, XN, ss1};
        pg8::gemm_phase<pg8::EpiResid<false>, pg8::StaticOrder, true, true>(lds, g, S, E);
    }
    SEAM();

    {
        pg8::Gemm g{XN, WFI, MTOK, 2 * DFF, DM}; pg8::StaticOrder S; S.init(MTOK, 2 * DFF, G, bx);
        pg8::EpiSwiGLU E{HB, ss1};
        pg8::gemm_phase<pg8::EpiSwiGLU, pg8::StaticOrder, true, true>(lds, g, S, E);
    }
    SEAM();

    {
        pg8::Gemm g{HB, WFO, MTOK, DM, DFF}; pg8::StaticOrder S; S.init(MTOK, DM, G, bx);
        pg8::EpiResid<true> E{nullptr, XN, ss2};
        pg8::gemm_phase<pg8::EpiResid<true>, pg8::StaticOrder, true, true>(lds, g, S, E);
    }
    {
        pg8::Gemm g{PBF, WPI, MTOK, DM, DPLE}; pg8::StaticOrder S; S.init(MTOK, DM, G, bx);
        pg8::EpiStoreBf16T E{TMP2};
        pg8::gemm_phase<pg8::EpiStoreBf16T, pg8::StaticOrder, true, true>(lds, g, S, E);
    }
    SEAM();

    {
        pg8::Gemm g{XN, WPG, MTOK, DM, DM}; pg8::StaticOrder S; S.init(MTOK, DM, G, bx);
        pg8::EpiPle E{XN, XB, TMP2, ss2, ss3};
        pg8::gemm_phase<pg8::EpiPle, pg8::StaticOrder, true, true>(lds, g, S, E);
    }
    SEAM();

    int tid8 = threadIdx.x; asm volatile("" : "+v"(tid8)); const int lane8 = tid8 & 63;
    for (int m = gw; m < MTOK; m += 2 * NGW) {
        const int m1 = m + NGW; const bool two = m1 < MTOK;
        const u32x4* xr0 = (const u32x4*)(XB + (size_t)m * DM) + lane8; const u32x4* xr1 = (const u32x4*)(XB + (size_t)(two ? m1 : m) * DM) + lane8;
        const f32x4* gr = (const f32x4*)g_final;
        u32x4 w0[4], w1[4];
#pragma unroll
        for (int j = 0; j < 4; ++j) { w0[j] = xr0[64 * j]; w1[j] = xr1[64 * j]; }
        const float rs0 = 1.0f / sqrtf(ss3[m] * (1.0f / DM) + EPS), rs1 = 1.0f / sqrtf(ss3[two ? m1 : m] * (1.0f / DM) + EPS);
        f32x4* o0 = (f32x4*)(out + (size_t)m * DM); f32x4* o1 = (f32x4*)(out + (size_t)m1 * DM);
#pragma unroll
        for (int j = 0; j < 4; ++j) { const int e = (lane8 + 64 * j) * 2; f32x4 a, b; const f32x4 g0 = gr[e], g1 = gr[e + 1];
            pg8::bf8_to_f32(w0[j], a, b); o0[e] = a * rs0 * g0; o0[e + 1] = b * rs0 * g1;
            if (two) { pg8::bf8_to_f32(w1[j], a, b); o1[e] = a * rs1 * g0; o1[e + 1] = b * rs1 * g1; } }
    }
}

extern "C" void kernel_launch(void* const* d_in, const int* in_sizes, int n_in, void* d_out, int out_size, void* d_ws, size_t ws_size, hipStream_t stream) {
    static int grid = 0;
    if (grid == 0) {
        if (n_in != 15 || out_size != MTOK * DM || ws_size < WS_END) { fprintf(stderr, "kernel_launch: unexpected problem (n_in %d, out %d, ws %zu)\n", n_in, out_size, ws_size); grid = -1; return; }
        int dev = 0, cus = 0, per_cu = 0;
        hipGetDevice(&dev);
        hipDeviceGetAttribute(&cus, hipDeviceAttributeMultiprocessorCount, dev);
        if (hipFuncSetAttribute((const void*)mega_fwd, hipFuncAttributeMaxDynamicSharedMemorySize, LDS_BYTES) != hipSuccess) { fprintf(stderr, "kernel_launch: hipFuncSetAttribute failed\n"); grid = -1; return; }
        if (hipOccupancyMaxActiveBlocksPerMultiprocessor(&per_cu, (const void*)mega_fwd, NWAVES * 64, LDS_BYTES) != hipSuccess || per_cu < 1) { per_cu = 1; (void)hipGetLastError(); }
        grid = cus * per_cu;
    }
    if (grid < 0) return;
    Args a{};
    for (int i = 0; i < 15; ++i) a.in[i] = (const float*)d_in[i];
    a.out = (float*)d_out; a.ws = (unsigned char*)d_ws;
    if (hipMemsetAsync((char*)d_ws + WS_CTL, 0, CTL_BYTES, stream) != hipSuccess) { fprintf(stderr, "kernel_launch: memset failed\n"); return; }
    void* kargs[] = {&a};
    hipError_t e = hipLaunchCooperativeKernel((const void*)mega_fwd, dim3(grid), dim3(NWAVES * 64), kargs, LDS_BYTES, stream);
    if (e != hipSuccess) fprintf(stderr, "cooperative launch failed: %s (grid %d)\n", hipGetErrorString(e), grid);
}
```
